# Optimizing an MI355X kernel written in HIP

```python
import math
import jax, jax.numpy as jnp
from jax import lax
import numpy as np

D_MODEL = 1024
BATCH = 4
SEQ = 8192
DEPTH = 2

N_EVEN = (DEPTH + 1) // 2
N_ODD = DEPTH // 2
HEAD_DIM = 64
CONV_GROUPS = 8
CONV_WIDTH = CONV_GROUPS * HEAD_DIM
ATTN_HEADS = 8
ATTN_WIDTH = ATTN_HEADS * HEAD_DIM
MIX_IN = 3 * CONV_WIDTH + 3 * ATTN_WIDTH
MIX_OUT = CONV_WIDTH + ATTN_WIDTH
SHORT_CONV_K = 3
DILATED_PAIRS = ((128, 1), (512, 4), (2048, 16))
REL_BUCKETS = 32
REL_MAX_DIST = 2048
LRU_WIDTH = D_MODEL
LRU_BLOCKS = 4
LRU_BLOCK = LRU_WIDTH // LRU_BLOCKS
REC_CONV_K = 4
LRU_C = 8.0
D_FF = 2816
PLE_DIM = 256
EPS = 1e-6

kernel_name = "hybrid_conv_dilattn_rglru_macaron"


def rms_norm(x, gain):
    xf = x.astype(jnp.float32)
    y = xf * lax.rsqrt(jnp.mean(xf * xf, axis=-1, keepdims=True) + EPS)
    return (y * gain.astype(jnp.float32)).astype(x.dtype)


def swiglu(h, w_gate, w_up, w_down):
    return (jax.nn.silu(h @ w_gate) * (h @ w_up)) @ w_down


def causal_depthwise_conv(x, w):
    k_taps = w.shape[0]
    s = x.shape[1]
    xp = jnp.pad(x, ((0, 0), (k_taps - 1, 0), (0, 0)))
    y = xp[:, 0:s] * w[0]
    for j in range(1, k_taps):
        y = y + xp[:, j:j + s] * w[j]
    return y


def rel_bucket(dist):
    max_exact = REL_BUCKETS // 2
    n = jnp.maximum(dist, 1).astype(jnp.float32)
    large = max_exact + (jnp.log(n / max_exact) / math.log(REL_MAX_DIST / max_exact)
                         * (REL_BUCKETS - max_exact)).astype(jnp.int32)
    large = jnp.minimum(large, REL_BUCKETS - 1)
    return jnp.where(dist < max_exact, dist, large)


def dilated_branch(q, k, v, rel_bias, window, dilation):
    b_, s_, h_, dh = q.shape
    d = dilation
    nw = window // d
    sub_len = s_ // d
    nb = -(-sub_len // nw)
    lp = nb * nw

    def strided(t, front):
        t = t.reshape(b_, sub_len, d, h_, dh)
        return jnp.pad(t, ((0, 0), (front, lp - sub_len), (0, 0), (0, 0), (0, 0)))

    q_b = strided(q, 0).reshape(b_, nb, nw, d, h_, dh)
    k_p = strided(k, nw).reshape(b_, nb + 1, nw, d, h_, dh)
    v_p = strided(v, nw).reshape(b_, nb + 1, nw, d, h_, dh)
    k_b = jnp.concatenate([k_p[:, :-1], k_p[:, 1:]], axis=2)
    v_b = jnp.concatenate([v_p[:, :-1], v_p[:, 1:]], axis=2)

    scores = jnp.einsum('bnqrhe,bnkrhe->bnrhqk', q_b, k_b).astype(jnp.float32) * (dh ** -0.5)
    qi = jnp.arange(nw)[:, None]
    kj = jnp.arange(2 * nw)[None, :]
    dist = qi + nw - kj
    key_pos = jnp.arange(nb)[:, None, None] * nw + kj[None] - nw
    valid = (dist >= 0)[None] & (dist <= nw)[None] & (key_pos >= 0)
    bucket = rel_bucket(jnp.clip(dist, 0, nw) * d)
    bias = jnp.transpose(rel_bias[bucket].astype(jnp.float32), (2, 0, 1))
    logits = jnp.where(valid[None, :, None, None], scores + bias, -jnp.inf)
    lse = jax.nn.logsumexp(logits, axis=-1)
    probs = jnp.exp(logits - lse[..., None])
    out = jnp.einsum('bnrhqk,bnkrhe->bnqrhe', probs.astype(v.dtype), v_b)
    out = out.reshape(b_, lp, d, h_, dh)[:, :sub_len].reshape(b_, s_, h_, dh)
    lse = jnp.transpose(lse, (0, 1, 4, 2, 3)).reshape(b_, lp, d, h_)[:, :sub_len].reshape(b_, s_, h_)
    return out, lse


def hybrid_mixer(h, w_in, conv_w, q_gain, k_gain, rel_bias, w_out):
    b_, s_, _ = h.shape
    z = h @ w_in
    cuts = np.cumsum([CONV_WIDTH, CONV_WIDTH, CONV_WIDTH, ATTN_WIDTH, ATTN_WIDTH])
    g_b, g_c, c_x, q, k, v = jnp.split(z, cuts, axis=-1)
    y_conv = g_b * causal_depthwise_conv(g_c * c_x, conv_w)
    qh = rms_norm(q.reshape(b_, s_, ATTN_HEADS, HEAD_DIM), q_gain)
    kh = rms_norm(k.reshape(b_, s_, ATTN_HEADS, HEAD_DIM), k_gain)
    vh = v.reshape(b_, s_, ATTN_HEADS, HEAD_DIM)
    outs = []
    lses = []
    for window, dil in DILATED_PAIRS:
        o, l = dilated_branch(qh, kh, vh, rel_bias, window, dil)
        outs.append(o)
        lses.append(l)
    wts = jax.nn.softmax(jnp.stack(lses), axis=0)
    y_attn = jnp.sum(wts[..., None] * jnp.stack(outs).astype(jnp.float32), axis=0)
    y_attn = y_attn.astype(h.dtype).reshape(b_, s_, ATTN_WIDTH)
    return jnp.concatenate([y_conv, y_attn], axis=-1) @ w_out


def rg_lru(xb, wa, ba, wx, bx, lam):
    b_, s_, _ = xb.shape
    xf = xb.astype(jnp.float32)
    xr = xf.reshape(b_, s_, LRU_BLOCKS, LRU_BLOCK)
    gate_a = jnp.einsum('bsgi,gij->bsgj', xr, wa.astype(jnp.float32)).reshape(b_, s_, LRU_WIDTH) + ba.astype(jnp.float32)
    gate_x = jnp.einsum('bsgi,gij->bsgj', xr, wx.astype(jnp.float32)).reshape(b_, s_, LRU_WIDTH) + bx.astype(jnp.float32)
    log_a = -LRU_C * jax.nn.sigmoid(gate_a) * jax.nn.softplus(-lam.astype(jnp.float32))
    a = jnp.exp(log_a)
    u = jnp.sqrt(-jnp.expm1(2.0 * log_a)) * (jax.nn.sigmoid(gate_x) * xf)

    def combine(left, right):
        a1, b1 = left
        a2, b2 = right
        return a1 * a2, a2 * b1 + b2

    _, hs = lax.associative_scan(combine, (a, u), axis=1)
    return hs.astype(xb.dtype)


def recurrent_mixer(h, w_in, conv_w, conv_b, wa, ba, wx, bx, lam, w_out):
    z = h @ w_in
    xb, yb = jnp.split(z, 2, axis=-1)
    xb = causal_depthwise_conv(xb, conv_w) + conv_b
    return (rg_lru(xb, wa, ba, wx, bx, lam) * jax.nn.gelu(yb)) @ w_out


def setup_inputs(seed: int = 0) -> dict:
    key = jax.random.key(seed)
    ks = iter(jax.random.split(key, 40))
    f32 = jnp.float32

    def dense(shape, fan_in):
        return jax.random.normal(next(ks), shape, f32) * (fan_in ** -0.5)

    def gain(shape):
        return 1.0 + 0.02 * jax.random.normal(next(ks), shape, f32)

    def small(shape, scale=0.02):
        return scale * jax.random.normal(next(ks), shape, f32)

    u = jax.random.uniform(next(ks), (N_ODD, LRU_WIDTH), f32, 0.9, 0.999)
    s_base = u ** (1.0 / LRU_C)
    lru_lambda = jnp.log(s_base) - jnp.log1p(-s_base)

    return {
        "x": jax.random.normal(next(ks), (BATCH, SEQ, D_MODEL), f32),
        "p": jax.random.normal(next(ks), (DEPTH, BATCH, SEQ, PLE_DIM), f32),
        "rel_bias": small((REL_BUCKETS, ATTN_HEADS), 0.1),
        "ffn1_norm": gain((DEPTH, D_MODEL)),
        "ffn1_w_gate": dense((DEPTH, D_MODEL, D_FF), D_MODEL),
        "ffn1_w_up": dense((DEPTH, D_MODEL, D_FF), D_MODEL),
        "ffn1_w_down": dense((DEPTH, D_FF, D_MODEL), D_FF),
        "mix_norm": gain((DEPTH, D_MODEL)),
        "hyb_w_in": dense((N_EVEN, D_MODEL, MIX_IN), D_MODEL),
        "hyb_conv_w": dense((N_EVEN, SHORT_CONV_K, CONV_WIDTH), SHORT_CONV_K),
        "hyb_q_gain": gain((N_EVEN, HEAD_DIM)),
        "hyb_k_gain": gain((N_EVEN, HEAD_DIM)),
        "hyb_w_out": dense((N_EVEN, MIX_OUT, D_MODEL), MIX_OUT),
        "rec_w_in": dense((N_ODD, D_MODEL, 2 * LRU_WIDTH), D_MODEL),
        "rec_conv_w": dense((N_ODD, REC_CONV_K, LRU_WIDTH), REC_CONV_K),
        "rec_conv_b": small((N_ODD, LRU_WIDTH)),
        "lru_wa": dense((N_ODD, LRU_BLOCKS, LRU_BLOCK, LRU_BLOCK), LRU_BLOCK),
        "lru_ba": small((N_ODD, LRU_WIDTH)),
        "lru_wx": dense((N_ODD, LRU_BLOCKS, LRU_BLOCK, LRU_BLOCK), LRU_BLOCK),
        "lru_bx": small((N_ODD, LRU_WIDTH)),
        "lru_lambda": lru_lambda,
        "rec_w_out": dense((N_ODD, LRU_WIDTH, D_MODEL), LRU_WIDTH),
        "ffn2_norm": gain((DEPTH, D_MODEL)),
        "ffn2_w_gate": dense((DEPTH, D_MODEL, D_FF), D_MODEL),
        "ffn2_w_up": dense((DEPTH, D_MODEL, D_FF), D_MODEL),
        "ffn2_w_down": dense((DEPTH, D_FF, D_MODEL), D_FF),
        "ple_norm": gain((DEPTH, D_MODEL)),
        "ple_w_gate": dense((DEPTH, D_MODEL, D_MODEL), D_MODEL),
        "ple_w_proj": dense((DEPTH, PLE_DIM, D_MODEL), PLE_DIM),
    }


def reference(x, p, rel_bias, ffn1_norm, ffn1_w_gate, ffn1_w_up, ffn1_w_down, mix_norm,
              hyb_w_in, hyb_conv_w, hyb_q_gain, hyb_k_gain, hyb_w_out,
              rec_w_in, rec_conv_w, rec_conv_b, lru_wa, lru_ba, lru_wx, lru_bx, lru_lambda, rec_w_out,
              ffn2_norm, ffn2_w_gate, ffn2_w_up, ffn2_w_down, ple_norm, ple_w_gate, ple_w_proj):
    h = x
    for i in range(DEPTH):
        h = h + 0.5 * swiglu(rms_norm(h, ffn1_norm[i]), ffn1_w_gate[i], ffn1_w_up[i], ffn1_w_down[i])
        hn = rms_norm(h, mix_norm[i])
        if i % 2 == 0:
            e = i // 2
            h = h + hybrid_mixer(hn, hyb_w_in[e], hyb_conv_w[e], hyb_q_gain[e], hyb_k_gain[e],
                                 rel_bias, hyb_w_out[e])
        else:
            o = i // 2
            h = h + recurrent_mixer(hn, rec_w_in[o], rec_conv_w[o], rec_conv_b[o], lru_wa[o], lru_ba[o],
                                    lru_wx[o], lru_bx[o], lru_lambda[o], rec_w_out[o])
        h = h + 0.5 * swiglu(rms_norm(h, ffn2_norm[i]), ffn2_w_gate[i], ffn2_w_up[i], ffn2_w_down[i])
        gate = jax.nn.sigmoid(rms_norm(h, ple_norm[i]) @ ple_w_gate[i])
        h = h + gate * (p[i] @ ple_w_proj[i])
    return h
```

```cpp
#include <hip/hip_runtime.h>
#include <hip/hip_cooperative_groups.h>
#include <cstdio>
#include <cstdint>
namespace cg = cooperative_groups;

#define LAS __attribute__((address_space(3)))
typedef unsigned short bf16_t;
typedef short bf16x8 __attribute__((ext_vector_type(8)));
typedef short s16x4 __attribute__((ext_vector_type(4)));
typedef float f32x4 __attribute__((ext_vector_type(4)));
typedef float f32x2 __attribute__((ext_vector_type(2)));
typedef unsigned u32x4 __attribute__((ext_vector_type(4)));
typedef unsigned u32x2 __attribute__((ext_vector_type(2)));

#ifndef MK_MULTI
#define MK_MULTI 0
#endif

constexpr int NBATCH = 4, SEQ = 8192, T = NBATCH * SEQ, D = 1024, FF = 2816, NH = 8, HD = 64, CW = 512, PLE = 256;
constexpr float EPS = 1e-6f;
constexpr float LOG2E = 1.4426950408889634f;
constexpr float QSCALE = 0.125f * LOG2E;
constexpr int NPHASE = 21;

constexpr size_t MiB = 1u << 20;
constexpr size_t WS_WTS = 1 * MiB;
constexpr size_t WS_HB0 = 97 * MiB, WS_HB1 = 161 * MiB, WS_ACT = 225 * MiB, WS_PP = 401 * MiB, WS_PB = 465 * MiB;
constexpr size_t WS_SS0 = 497 * MiB, WS_SS1 = 499 * MiB, WS_LSE = 501 * MiB, WS_AGG = 504 * MiB, WS_BIAS = 506 * MiB, WS_END = 512 * MiB;
constexpr size_t W_GU = WS_WTS;
constexpr size_t W_DN = W_GU + 44 * MiB;
constexpr size_t W_HIN = W_DN + 22 * MiB;
constexpr size_t W_HOUT = W_HIN + 6 * MiB;
constexpr size_t W_RIN = W_HOUT + 2 * MiB;
constexpr size_t W_LRU = W_RIN + 4 * MiB;
constexpr size_t W_ROUT = W_LRU + 1 * MiB;
constexpr size_t W_PG = W_ROUT + 2 * MiB;
constexpr size_t W_PPW = W_PG + 4 * MiB;
static_assert(W_PPW + 1 * MiB <= WS_HB0, "weights fit");

__device__ __forceinline__ unsigned cvt_pk_bf16(float lo, float hi) { unsigned r; asm volatile("v_cvt_pk_bf16_f32 %0, %1, %2" : "=v"(r) : "v"(lo), "v"(hi)); return r; }
__device__ __forceinline__ float bf_lo(unsigned w) { return __uint_as_float(w << 16); }
__device__ __forceinline__ float bf_hi(unsigned w) { return __uint_as_float(w & 0xffff0000u); }
__device__ __forceinline__ float fast_sigmoid(float x) { return __builtin_amdgcn_rcpf(1.0f + __builtin_amdgcn_exp2f(-x * LOG2E)); }
__device__ __forceinline__ float red4_sum(float x) {
    auto r = __builtin_amdgcn_permlane16_swap(__float_as_uint(x), __float_as_uint(x), false, false); x = __uint_as_float(r[0]) + __uint_as_float(r[1]);
    auto q = __builtin_amdgcn_permlane32_swap(__float_as_uint(x), __float_as_uint(x), false, false); return __uint_as_float(q[0]) + __uint_as_float(q[1]);
}
__device__ __forceinline__ float red4_max(float x) {
    auto r = __builtin_amdgcn_permlane16_swap(__float_as_uint(x), __float_as_uint(x), false, false); x = fmaxf(__uint_as_float(r[0]), __uint_as_float(r[1]));
    auto q = __builtin_amdgcn_permlane32_swap(__float_as_uint(x), __float_as_uint(x), false, false); return fmaxf(__uint_as_float(q[0]), __uint_as_float(q[1]));
}
__device__ __forceinline__ float wave_sum(float v) {
#pragma unroll
    for (int o = 1; o < 64; o <<= 1) v += __shfl_xor(v, o);
    return v;
}

constexpr int RS_OFF = 131072 + 2048;
namespace pg8 {
constexpr int BM = 256, BK = 64, HALF = 128, HTB = HALF * BK * 2, STAGE_BYTES = 8 * HTB, NXCD = 8, WGM = 8;
__host__ __device__ __forceinline__ int lds_byte(int r, int c) { const int st = (r >> 4) * 2 + (c >> 5), rr = r & 15, cc = c & 31, ob = rr * 64 + cc * 2; return st * 1024 + (ob ^ (((ob >> 9) & 1) << 5)); }
__host__ __device__ __forceinline__ void stage_rc(int b, int& R, int& C) { const int st = b / 1024, sb = b % 1024, swz = sb ^ (((sb >> 9) & 1) << 5); R = (st >> 1) * 16 + swz / 64; C = (st & 1) * 32 + (swz % 64) / 2; }
__host__ __device__ __forceinline__ int perm32(int rho) { const int n = rho >> 4, i = rho & 15; return 8 * (i >> 2) + 4 * n + (i & 3); }

struct Unit { int pm, pn; };
struct Gemm { const bf16_t* A; const bf16_t* Bt; int M, N, K, lda, ldb, a_grp_shift, a_grp_bytes; };

struct StaticOrder {
    int nM, nN, nwg, G, c;
    __device__ void init(int M, int N, int G_, int c_) { nM = M / BM; nN = N / BM; nwg = nM * nN; G = G_; c = c_; }
    __device__ bool next(int i, Unit& u) const {
        const long L = (long)i * G + c; if (L >= nwg) return false;
        int wgid = (int)L; { const int q = nwg / NXCD, r = nwg % NXCD, xcd = wgid % NXCD, off = wgid / NXCD; wgid = (xcd < r ? xcd * (q + 1) : r * (q + 1) + (xcd - r) * q) + off; }
        const int nig = WGM * nN, gid = wgid / nig, fm = gid * WGM, gsz = (nM - fm) < WGM ? (nM - fm) : WGM;
        u.pm = fm + ((wgid % nig) % gsz); u.pn = (wgid % nig) / gsz; return true;
    }
};

template <class Epi>
__device__ __forceinline__ void gemm_phase(LAS unsigned char* lds, const int tid, const Gemm g, const StaticOrder& S, const Epi& E) {
    const int wid = __builtin_amdgcn_readfirstlane(tid >> 6), lane = tid & 63, wr = wid >> 2, wc = wid & 3, fr = lane & 15, fq = lane >> 4;
    const int K = g.K, nt = K / BK;
    unsigned voffA[2], voffB[2];
#pragma unroll
    for (int i = 0; i < 2; ++i) { int R, C; stage_rc(tid * 16 + i * 8192, R, C); const int Rb = (R & ~31) + perm32(R & 31);
        voffA[i] = (unsigned)(R * g.lda + C) * 2u; voffB[i] = (unsigned)(Rb * g.ldb + C) * 2u; }
    const size_t kstep = (size_t)(BK * 2);
    const size_t hstepA = (size_t)HALF * g.lda * 2, hstepB = (size_t)HALF * g.ldb * 2;
    const size_t tstepA = 2 * hstepA, tstepB = 2 * hstepB;
    const unsigned ldsw = (unsigned)wid * 1024u;
    const int aoff = lds_byte(wr * 64 + fr, fq * 8), boff = lds_byte(wc * 32 + fr, fq * 8);
#define PG8_SA(b, h) (((b) * 2 + (h)) * HTB)
#define PG8_SB(b, h) ((4 + (b) * 2 + (h)) * HTB)
#define PG8_STAGE(bufoff, gbase, voff) do { _Pragma("unroll") for (int _i = 0; _i < 2; ++_i) \
        __builtin_amdgcn_global_load_lds((const unsigned*)((const char*)(gbase) + (voff)[_i]), (LAS unsigned*)(lds + (bufoff) + ldsw + _i * 8192), 16, 0, 0); } while (0)
#define PG8_LDA(dst, b, h) do { _Pragma("unroll") for (int m = 0; m < 4; ++m) _Pragma("unroll") for (int k = 0; k < 2; ++k) dst[m][k] = *(const LAS bf16x8*)(lds + PG8_SA(b, h) + aoff + m * 2048 + k * 1024); } while (0)
#define PG8_LDB(dst, b, h) do { _Pragma("unroll") for (int n = 0; n < 2; ++n) _Pragma("unroll") for (int k = 0; k < 2; ++k) dst[n][k] = *(const LAS bf16x8*)(lds + PG8_SB(b, h) + boff + n * 2048 + k * 1024); } while (0)
#define PG8_MMA(ai, bj, At, Bt) do { __builtin_amdgcn_s_setprio(1); _Pragma("unroll") for (int m = 0; m < 4; ++m) _Pragma("unroll") for (int n = 0; n < 2; ++n) _Pragma("unroll") for (int k = 0; k < 2; ++k) \
        acc[ai][bj][m][n] = __builtin_amdgcn_mfma_f32_16x16x32_bf16(Bt[n][k], At[m][k], acc[ai][bj][m][n], 0, 0, 0); __builtin_amdgcn_s_setprio(0); } while (0)
#define PG8_WAIT_V(n) asm volatile("s_waitcnt vmcnt(" #n ")" ::: "memory")
#define PG8_WAIT_L(n) asm volatile("s_waitcnt lgkmcnt(" #n ")" ::: "memory")
#define PG8_BAR __builtin_amdgcn_s_barrier()
#define PG8_SCHED __builtin_amdgcn_sched_barrier(0)
    Unit cur, nxt; int ui = 0;
    if (!S.next(0, cur)) return;
    f32x4 acc[2][2][4][2];
#pragma unroll
    for (int a = 0; a < 2; ++a)
#pragma unroll
        for (int b = 0; b < 2; ++b)
#pragma unroll
            for (int m = 0; m < 4; ++m)
#pragma unroll
                for (int n = 0; n < 2; ++n) acc[a][b][m][n] = (f32x4){0.f, 0.f, 0.f, 0.f};
    bf16x8 At[4][2], B0[2][2], B1[2][2];
    const char* cA = (const char*)g.A + (size_t)cur.pm * tstepA + (size_t)(cur.pn >> g.a_grp_shift) * g.a_grp_bytes;
    const char* cB = (const char*)g.Bt + (size_t)cur.pn * tstepB;
#ifndef PG8_SP2
#define PG8_SP2 1
#endif
#if PG8_SP2
    PG8_STAGE(PG8_SB(0, 0), cB, voffB); PG8_STAGE(PG8_SB(0, 1), cB + hstepB, voffB); PG8_STAGE(PG8_SA(0, 0), cA, voffA); PG8_STAGE(PG8_SA(0, 1), cA + hstepA, voffA);
    if (wr == 1) PG8_BAR;
    PG8_WAIT_V(2); PG8_BAR;
    PG8_STAGE(PG8_SB(1, 0), cB + kstep, voffB); PG8_STAGE(PG8_SA(1, 0), cA + kstep, voffA); PG8_STAGE(PG8_SB(1, 1), cB + hstepB + kstep, voffB);
    PG8_WAIT_V(6); PG8_BAR;
#else
    PG8_STAGE(PG8_SB(0, 0), cB, voffB); PG8_STAGE(PG8_SA(0, 0), cA, voffA); PG8_STAGE(PG8_SB(0, 1), cB + hstepB, voffB); PG8_STAGE(PG8_SA(0, 1), cA + hstepA, voffA);
    if (wr == 1) PG8_BAR;
    PG8_WAIT_V(4); PG8_BAR;
    PG8_STAGE(PG8_SB(1, 0), cB + kstep, voffB); PG8_STAGE(PG8_SA(1, 0), cA + kstep, voffA); PG8_STAGE(PG8_SB(1, 1), cB + hstepB + kstep, voffB);
    PG8_WAIT_V(6); PG8_BAR;
#endif
    for (;;) {
        const bool has_next = S.next(ui + 1, nxt);
        const char* nA = has_next ? (const char*)g.A + (size_t)nxt.pm * tstepA + (size_t)(nxt.pn >> g.a_grp_shift) * g.a_grp_bytes : cA;
        const char* nB = has_next ? (const char*)g.Bt + (size_t)nxt.pn * tstepB : cB;
        for (int t = 0; t < nt; t += 2) {
            const bool last = (t == nt - 2);
            const char* a1 = cA + (size_t)(t + 1) * kstep;
            const char* a2 = last ? nA : cA + (size_t)(t + 2) * kstep; const char* b2 = last ? nB : cB + (size_t)(t + 2) * kstep;
            const char* a3 = a2 + kstep; const char* b3 = b2 + kstep;
            if constexpr (Epi::SS_LDS) { if (last) {
                const char* sp = (const char*)E.ss + (size_t)cur.pm * (256 * 64) + (size_t)tid * 16;
                __builtin_amdgcn_global_load_lds((const unsigned*)sp, (LAS unsigned*)(lds + RS_OFF + ldsw), 16, 0, 0);
                __builtin_amdgcn_global_load_lds((const unsigned*)(sp + 8192), (LAS unsigned*)(lds + RS_OFF + 8192 + ldsw), 16, 0, 0); } }
#if PG8_SP2
            PG8_LDB(B0, 0, 0); PG8_LDB(B1, 0, 1); PG8_SCHED; PG8_LDA(At, 0, 0); PG8_STAGE(PG8_SA(1, 1), a1 + hstepA, voffA);
            PG8_WAIT_V(8); PG8_WAIT_L(0); PG8_BAR; PG8_MMA(0, 0, At, B0); PG8_MMA(0, 1, At, B1); PG8_BAR; PG8_SCHED;
            PG8_LDA(At, 0, 1); PG8_STAGE(PG8_SB(0, 0), b2, voffB); PG8_STAGE(PG8_SB(0, 1), b2 + hstepB, voffB); PG8_STAGE(PG8_SA(0, 0), a2, voffA);
            PG8_WAIT_V(8); PG8_WAIT_L(0); PG8_BAR; PG8_MMA(1, 0, At, B0); PG8_MMA(1, 1, At, B1); PG8_BAR; PG8_SCHED;
            PG8_LDB(B0, 1, 0); PG8_LDB(B1, 1, 1); PG8_SCHED; PG8_LDA(At, 1, 0); PG8_STAGE(PG8_SA(0, 1), a2 + hstepA, voffA);
            PG8_WAIT_V(8); PG8_WAIT_L(0); PG8_BAR; PG8_MMA(0, 0, At, B0); PG8_MMA(0, 1, At, B1); PG8_BAR; PG8_SCHED;
            PG8_LDA(At, 1, 1); PG8_STAGE(PG8_SB(1, 0), b3, voffB); PG8_STAGE(PG8_SB(1, 1), b3 + hstepB, voffB); PG8_STAGE(PG8_SA(1, 0), a3, voffA);
            PG8_WAIT_V(8); PG8_WAIT_L(0); PG8_BAR; PG8_MMA(1, 0, At, B0); PG8_MMA(1, 1, At, B1); PG8_BAR; PG8_SCHED;
#else
            PG8_LDB(B0, 0, 0); PG8_SCHED; PG8_LDA(At, 0, 0); PG8_STAGE(PG8_SA(1, 1), a1 + hstepA, voffA);
            PG8_WAIT_L(8); PG8_BAR; PG8_WAIT_L(0); PG8_MMA(0, 0, At, B0); PG8_BAR; PG8_SCHED;
            PG8_LDB(B1, 0, 1); PG8_STAGE(PG8_SB(0, 0), b2, voffB);
            PG8_BAR; PG8_WAIT_L(0); PG8_MMA(0, 1, At, B1); PG8_BAR;
            PG8_LDA(At, 0, 1); PG8_STAGE(PG8_SA(0, 0), a2, voffA);
            PG8_BAR; PG8_WAIT_L(0); PG8_MMA(1, 0, At, B0); PG8_BAR; PG8_SCHED;
            PG8_STAGE(PG8_SB(0, 1), b2 + hstepB, voffB);
            PG8_WAIT_V(6); PG8_BAR; PG8_MMA(1, 1, At, B1); PG8_BAR;
            PG8_LDB(B0, 1, 0); PG8_SCHED; PG8_LDA(At, 1, 0); PG8_STAGE(PG8_SA(0, 1), a2 + hstepA, voffA);
            PG8_WAIT_L(8); PG8_BAR; PG8_WAIT_L(0); PG8_MMA(0, 0, At, B0); PG8_BAR; PG8_SCHED;
            PG8_LDB(B1, 1, 1); PG8_STAGE(PG8_SB(1, 0), b3, voffB);
            PG8_BAR; PG8_WAIT_L(0); PG8_MMA(0, 1, At, B1); PG8_BAR;
            PG8_LDA(At, 1, 1); PG8_STAGE(PG8_SA(1, 0), a3, voffA);
            PG8_BAR; PG8_WAIT_L(0); PG8_MMA(1, 0, At, B0); PG8_BAR; PG8_SCHED;
            PG8_STAGE(PG8_SB(1, 1), b3 + hstepB, voffB);
            PG8_WAIT_V(6); PG8_BAR; PG8_MMA(1, 1, At, B1); PG8_BAR;
#endif
        }
        if (wr == 0) PG8_BAR;
        E(acc, cur, wr, wc, fr, fq);
        if (!has_next) break;
#pragma unroll
        for (int a = 0; a < 2; ++a)
#pragma unroll
            for (int b = 0; b < 2; ++b)
#pragma unroll
                for (int m = 0; m < 4; ++m)
#pragma unroll
                    for (int n = 0; n < 2; ++n) acc[a][b][m][n] = (f32x4){0.f, 0.f, 0.f, 0.f};
        cur = nxt; cA = nA; cB = nB; ++ui;
        if (wr == 1) PG8_BAR;
    }
    PG8_WAIT_V(0);
    PG8_BAR;
#undef PG8_SA
#undef PG8_SB
#undef PG8_STAGE
#undef PG8_LDA
#undef PG8_LDB
#undef PG8_MMA
#undef PG8_WAIT_V
#undef PG8_WAIT_L
#undef PG8_BAR
#undef PG8_SCHED
}
}
using pg8::Unit;
typedef f32x4 Acc[2][2][4][2];

__device__ __forceinline__ float row_rs_lds(int rt, int fq) {
    extern __shared__ __attribute__((aligned(16))) unsigned char lds_raw_[];
    const f32x4 v = *(const LAS f32x4*)((LAS unsigned char*)lds_raw_ + RS_OFF + rt * 64 + fq * 16);
    float s = (v[0] + v[1]) + (v[2] + v[3]);
    s = red4_sum(s);
    return __builtin_amdgcn_rsqf(s * (1.0f / D) + EPS);
}
#define ROW_RS(u, ai, m) row_rs_lds((ai) * 128 + wr * 64 + (m) * 16 + fr, fq)
__device__ __forceinline__ u32x4 pack8(const f32x4 a, const f32x4 b) {
    u32x4 w; w.x = cvt_pk_bf16(a[0], a[1]); w.y = cvt_pk_bf16(a[2], a[3]); w.z = cvt_pk_bf16(b[0], b[1]); w.w = cvt_pk_bf16(b[2], b[3]); return w;
}
#define ROWLOOP for (int ai = 0; ai < 2; ++ai) _Pragma("unroll") for (int m = 0; m < 4; ++m)
#define ROW_OF(u, ai, m) ((u).pm * 256 + (ai) * 128 + wr * 64 + (m) * 16 + fr)

struct EpiGU {
    static constexpr bool SS_LDS = true;
    const float* ss; bf16_t* act;
    __device__ __forceinline__ void operator()(const Acc& acc, const Unit& u, int wr, int wc, int fr, int fq) const {
        const int col0 = u.pn * 128 + wc * 32 + fq * 8;
#pragma unroll
        ROWLOOP {
            const int row = ROW_OF(u, ai, m); const float rs = ROW_RS(u, ai, m); const float c1 = -rs * LOG2E, rs2 = rs * rs;
            f32x4 o[2];
#pragma unroll
            for (int n = 0; n < 2; ++n) {
                const f32x4 gv = acc[ai][0][m][n], gu = gv * acc[ai][1][m][n], t = gv * c1; f32x4 r;
#pragma unroll
                for (int e = 0; e < 4; ++e) r[e] = __builtin_amdgcn_rcpf(1.0f + __builtin_amdgcn_exp2f(t[e]));
                o[n] = gu * (r * rs2);
            }
            *(u32x4*)(act + (size_t)row * FF + col0) = pack8(o[0], o[1]);
        }
    }
};
__device__ __forceinline__ f32x4 bf4_lo(const u32x4 w) { return (f32x4){bf_lo(w.x), bf_hi(w.x), bf_lo(w.y), bf_hi(w.y)}; }
__device__ __forceinline__ f32x4 bf4_hi(const u32x4 w) { return (f32x4){bf_lo(w.z), bf_hi(w.z), bf_lo(w.w), bf_hi(w.w)}; }
template <bool BASE_F32> struct EpiRes {
    static constexpr bool SS_LDS = false;
    const void* base; bf16_t* hb; float* ss_out; float scale;
    __device__ __forceinline__ void operator()(const Acc& acc, const Unit& u, int wr, int wc, int fr, int fq) const {
        const int colb = u.pn * 256 + wc * 32 + fq * 8;
#pragma unroll
        for (int ai = 0; ai < 2; ++ai) {
            f32x4 hv[4][2][2];
            if constexpr (BASE_F32) {
#pragma unroll
                for (int m = 0; m < 4; ++m)
#pragma unroll
                    for (int bj = 0; bj < 2; ++bj) { const size_t off = (size_t)ROW_OF(u, ai, m) * D + colb + bj * 128; hv[m][bj][0] = *(const f32x4*)((const float*)base + off); hv[m][bj][1] = *(const f32x4*)((const float*)base + off + 4); }
            } else {
                u32x4 hw[4][2];
#pragma unroll
                for (int m = 0; m < 4; ++m)
#pragma unroll
                    for (int bj = 0; bj < 2; ++bj) hw[m][bj] = *(const u32x4*)((const bf16_t*)base + (size_t)ROW_OF(u, ai, m) * D + colb + bj * 128);
#pragma unroll
                for (int m = 0; m < 4; ++m)
#pragma unroll
                    for (int bj = 0; bj < 2; ++bj) { hv[m][bj][0] = bf4_lo(hw[m][bj]); hv[m][bj][1] = bf4_hi(hw[m][bj]); }
            }
#pragma unroll
            for (int m = 0; m < 4; ++m) {
                const int row = ROW_OF(u, ai, m); float sq = 0.f;
#pragma unroll
                for (int bj = 0; bj < 2; ++bj) {
                    const size_t off = (size_t)row * D + colb + bj * 128;
                    const f32x4 h0 = hv[m][bj][0] + acc[ai][bj][m][0] * scale, h1 = hv[m][bj][1] + acc[ai][bj][m][1] * scale;
                    *(u32x4*)(hb + off) = pack8(h0, h1);
                    sq += (h0[0] * h0[0] + h0[1] * h0[1]) + (h0[2] * h0[2] + h0[3] * h0[3]) + (h1[0] * h1[0] + h1[1] * h1[1]) + (h1[2] * h1[2] + h1[3] * h1[3]);
                }
                sq = red4_sum(sq);
                if (fq == 0) ss_out[(size_t)row * 16 + u.pn * 4 + wc] = sq;
            }
            asm volatile("" ::: "memory");
        }
    }
};
template <bool OUT_F32> struct EpiPle {
    static constexpr bool SS_LDS = true;
    const float* ss; const bf16_t* pp; const bf16_t* hin; float* outf; bf16_t* hb; float* ss_out;
    __device__ __forceinline__ void operator()(const Acc& acc, const Unit& u, int wr, int wc, int fr, int fq) const {
        const int colb = u.pn * 256 + wc * 32 + fq * 8;
#pragma unroll
        for (int ai = 0; ai < 2; ++ai) {
            u32x4 hw[4][2], pv[4][2]; float rsv[4];
#pragma unroll
            for (int m = 0; m < 4; ++m) { const int row = ROW_OF(u, ai, m); rsv[m] = ROW_RS(u, ai, m);
#pragma unroll
                for (int bj = 0; bj < 2; ++bj) { const size_t off = (size_t)row * D + colb + bj * 128; hw[m][bj] = *(const u32x4*)(hin + off); pv[m][bj] = *(const u32x4*)(pp + off); } }
#pragma unroll
            for (int m = 0; m < 4; ++m) { const int row = ROW_OF(u, ai, m); const float rs = rsv[m]; float sq = 0.f;
#pragma unroll
                for (int bj = 0; bj < 2; ++bj) {
                    const size_t off = (size_t)row * D + colb + bj * 128;
                    f32x4 h0 = bf4_lo(hw[m][bj]), h1 = bf4_hi(hw[m][bj]); const f32x4 p0 = bf4_lo(pv[m][bj]), p1 = bf4_hi(pv[m][bj]);
#pragma unroll
                    for (int e = 0; e < 4; ++e) { h0[e] += fast_sigmoid(acc[ai][bj][m][0][e] * rs) * p0[e]; h1[e] += fast_sigmoid(acc[ai][bj][m][1][e] * rs) * p1[e]; }
                    if constexpr (OUT_F32) { *(f32x4*)(outf + off) = h0; *(f32x4*)(outf + off + 4) = h1; }
                    else { *(u32x4*)(hb + off) = pack8(h0, h1);
                        sq += (h0[0] * h0[0] + h0[1] * h0[1]) + (h0[2] * h0[2] + h0[3] * h0[3]) + (h1[0] * h1[0] + h1[1] * h1[1]) + (h1[2] * h1[2] + h1[3] * h1[3]); }
                }
                if constexpr (!OUT_F32) { sq = red4_sum(sq); if (fq == 0) ss_out[(size_t)row * 16 + u.pn * 4 + wc] = sq; }
            }
            asm volatile("" ::: "memory");
        }
    }
};
struct EpiPlain {
    static constexpr bool SS_LDS = false;
    bf16_t* o;
    __device__ __forceinline__ void operator()(const Acc& acc, const Unit& u, int wr, int wc, int fr, int fq) const {
#pragma unroll
        ROWLOOP {
            const int row = ROW_OF(u, ai, m);
#pragma unroll
            for (int bj = 0; bj < 2; ++bj) *(u32x4*)(o + (size_t)row * D + u.pn * 256 + bj * 128 + wc * 32 + fq * 8) = pack8(acc[ai][bj][m][0], acc[ai][bj][m][1]);
        }
    }
};
struct EpiHin {
    static constexpr bool SS_LDS = true;
    const float* ss; bf16_t *GB, *U, *Q, *Kb, *V; const float *qg, *kg;
    __device__ __forceinline__ void operator()(const Acc& acc, const Unit& u, int wr, int wc, int fr, int fq) const {
        const int pn = u.pn;
        if (pn < 2 || pn >= 10) {
            bf16_t* o = pn < 2 ? GB : V; const int ct = (pn < 2 ? pn : pn - 10) * 256;
#pragma unroll
            ROWLOOP { const int row = ROW_OF(u, ai, m); const float rs = ROW_RS(u, ai, m);
#pragma unroll
                for (int bj = 0; bj < 2; ++bj) *(u32x4*)(o + (size_t)row * CW + ct + bj * 128 + wc * 32 + fq * 8) = pack8(acc[ai][bj][m][0] * rs, acc[ai][bj][m][1] * rs); }
        } else if (pn < 6) {
            const int ct = (pn - 2) * 128;
#pragma unroll
            ROWLOOP { const int row = ROW_OF(u, ai, m); const float rs = ROW_RS(u, ai, m); const float r2 = rs * rs;
                *(u32x4*)(U + (size_t)row * CW + ct + wc * 32 + fq * 8) = pack8(acc[ai][0][m][0] * acc[ai][1][m][0] * r2, acc[ai][0][m][1] * acc[ai][1][m][1] * r2); }
        } else {
            const bool isq = pn < 8; bf16_t* o = isq ? Q : Kb; const float* gp = isq ? qg : kg; const float sc = isq ? QSCALE : 1.0f;
            const int head = 4 * (pn & 1) + wc;
            f32x4 gn[2][2];
#pragma unroll
            for (int bj = 0; bj < 2; ++bj)
#pragma unroll
                for (int n = 0; n < 2; ++n) gn[bj][n] = *(const f32x4*)(gp + bj * 32 + fq * 8 + n * 4) * sc;
#pragma unroll
            ROWLOOP { const int row = ROW_OF(u, ai, m); const float rs = ROW_RS(u, ai, m);
                f32x4 v[2][2]; float sq = 0.f;
#pragma unroll
                for (int bj = 0; bj < 2; ++bj)
#pragma unroll
                    for (int n = 0; n < 2; ++n) { v[bj][n] = acc[ai][bj][m][n] * rs; sq += (v[bj][n][0] * v[bj][n][0] + v[bj][n][1] * v[bj][n][1]) + (v[bj][n][2] * v[bj][n][2] + v[bj][n][3] * v[bj][n][3]); }
                sq = red4_sum(sq);
                const float rr = __builtin_amdgcn_rsqf(sq * (1.0f / HD) + EPS);
#pragma unroll
                for (int bj = 0; bj < 2; ++bj) *(u32x4*)(o + (size_t)row * CW + head * 64 + bj * 32 + fq * 8) = pack8(v[bj][0] * rr * gn[bj][0], v[bj][1] * rr * gn[bj][1]);
            }
        }
    }
};
struct EpiRin {
    static constexpr bool SS_LDS = true;
    const float* ss; bf16_t *XB, *GY;
    __device__ __forceinline__ void operator()(const Acc& acc, const Unit& u, int wr, int wc, int fr, int fq) const {
        const bool isx = u.pn < 4; bf16_t* o = isx ? XB : GY; const int ct = (u.pn & 3) * 256;
#pragma unroll
        ROWLOOP { const int row = ROW_OF(u, ai, m); const float rs = ROW_RS(u, ai, m);
#pragma unroll
            for (int bj = 0; bj < 2; ++bj) {
                f32x4 v0 = acc[ai][bj][m][0] * rs, v1 = acc[ai][bj][m][1] * rs;
                if (!isx) {
#pragma unroll
                    for (int e = 0; e < 4; ++e) { float x = v0[e]; v0[e] = x * fast_sigmoid(1.5957691216f * (x + 0.044715f * x * x * x)); x = v1[e]; v1[e] = x * fast_sigmoid(1.5957691216f * (x + 0.044715f * x * x * x)); }
                }
                *(u32x4*)(o + (size_t)row * D + ct + bj * 128 + wc * 32 + fq * 8) = pack8(v0, v1);
            } }
    }
};
__device__ __forceinline__ float neg_expm1(float x) {
    const float p = -x * (1.0f + x * (0.5f + x * (0.16666667f + x * (0.041666668f + x * (0.0083333338f + x * 0.0013888889f)))));
    const float q = 1.0f - __expf(x);
    return x > -0.3f ? p : q;
}
struct EpiGates {
    static constexpr bool SS_LDS = false;
    const bf16_t* xc; const float *ba, *bx, *sp8; bf16_t* Lout; bf16_t* Uout;
    __device__ __forceinline__ void operator()(const Acc& acc, const Unit& u, int wr, int wc, int fr, int fq) const {
        const int c0 = (u.pn >> 1) * 256 + (u.pn & 1) * 128 + wc * 32 + fq * 8;
        u32x4 xw[2][4];
#pragma unroll
        for (int ai = 0; ai < 2; ++ai)
#pragma unroll
            for (int m = 0; m < 4; ++m) xw[ai][m] = *(const u32x4*)(xc + (size_t)ROW_OF(u, ai, m) * D + c0);
        f32x4 vba[2], vbx[2], vsp[2];
#pragma unroll
        for (int n = 0; n < 2; ++n) { vba[n] = *(const f32x4*)(ba + c0 + 4 * n); vbx[n] = *(const f32x4*)(bx + c0 + 4 * n); vsp[n] = *(const f32x4*)(sp8 + c0 + 4 * n); }
#pragma unroll
        ROWLOOP { const int row = ROW_OF(u, ai, m); const size_t off = (size_t)row * D + c0;
            const u32x4 w = xw[ai][m];
            const f32x4 xv[2] = {{bf_lo(w.x), bf_hi(w.x), bf_lo(w.y), bf_hi(w.y)}, {bf_lo(w.z), bf_hi(w.z), bf_lo(w.w), bf_hi(w.w)}};
            f32x4 av[2], uv[2];
#pragma unroll
            for (int n = 0; n < 2; ++n)
#pragma unroll
                for (int e = 0; e < 4; ++e) {
                    const float ra = fast_sigmoid(acc[ai][0][m][n][e] + vba[n][e]);
                    const float la = -ra * vsp[n][e];
                    av[n][e] = la * LOG2E;
                    uv[n][e] = __builtin_sqrtf(neg_expm1(2.0f * la)) * fast_sigmoid(acc[ai][1][m][n][e] + vbx[n][e]) * xv[n][e];
                }
            *(u32x4*)(Lout + off) = pack8(av[0], av[1]);
            *(u32x4*)(Uout + off) = pack8(uv[0], uv[1]);
        }
    }
};

struct Job { const float* W; const float* gain; bf16_t* WT; int K, N, mode, row_base, start, pad; };
constexpr int NJOBS = 28;
struct Args { const float* in[29]; float* out; unsigned char* ws; Job jobs[NJOBS]; int ph_lo, ph_hi, nitems, pad; };

constexpr int LDS_BYTES = 131072 + 2048 + 16384;

__device__ __forceinline__ int map_pair(int n0, int up) { return (n0 >> 7) * 256 + up * 128 + (n0 & 127); }
__device__ __forceinline__ int map_head(int l) { const int head = l >> 6, x0 = l & 63; return (head >> 2) * 256 + 128 * (x0 >> 5) + 32 * (head & 3); }
__device__ __forceinline__ int map_row(int mode, int n0) {
    if (mode == 0) return n0;
    if (mode == 1) return map_pair(n0, 0);
    if (mode == 2) return map_pair(n0, 1);
    const int sec = n0 >> 9, l = n0 & 511;
    if (sec == 0) return l;
    if (sec == 1) return 512 + map_pair(l, 0);
    if (sec == 2) return 512 + map_pair(l, 1);
    if (sec == 3) return 1536 + map_head(l);
    if (sec == 4) return 2048 + map_head(l);
    return 2560 + l;
}
struct P0Item { const float* src; const float* gain; bf16_t* dst; int K, k0; };
__device__ __forceinline__ void p0_decode(const Args& args, int it, P0Item& o, int& N) {
    int j = 0;
#pragma unroll 1
    for (int q = 1; q < NJOBS; ++q) if (it >= args.jobs[q].start) j = q;
    const Job& jb = args.jobs[j]; const int item = it - jb.start;
    const int K = jb.K; N = jb.N; const int nblk = N / 32, kb = item / nblk, nb = item % nblk, k0 = 64 * kb, n0 = 32 * nb;
    o.src = jb.W + (size_t)k0 * N + n0; o.gain = jb.gain ? jb.gain + k0 : nullptr; o.K = K; o.k0 = k0;
    o.dst = jb.WT + (size_t)(jb.row_base + map_row(jb.mode, n0)) * K + k0;
}
__device__ __forceinline__ void p0_load(const P0Item& p, int N, int lane, f32x4 (&v)[8], float (&gk)[8]) {
    const int r8 = lane >> 3, c4 = lane & 7;
#pragma unroll
    for (int i = 0; i < 8; ++i) { const int kk = 8 * i + r8; v[i] = *(const f32x4*)(p.src + (size_t)kk * N + 4 * c4); gk[i] = p.gain ? p.gain[kk] : 1.0f; }
}
__device__ __forceinline__ void p0_emit(const P0Item& p, LAS float* scr, int lane, const f32x4 (&v)[8], const float (&gk)[8]) {
    const int r8 = lane >> 3, c4 = lane & 7;
#pragma unroll
    for (int i = 0; i < 8; ++i) { const int kk = 8 * i + r8; LAS float* d = scr + kk * 33 + 4 * c4; d[0] = v[i][0] * gk[i]; d[1] = v[i][1] * gk[i]; d[2] = v[i][2] * gk[i]; d[3] = v[i][3] * gk[i]; }
    asm volatile("s_waitcnt lgkmcnt(0)" ::: "memory");
    const int c = lane & 7;
#pragma unroll
    for (int j = 0; j < 4; ++j) { const int n = (lane >> 3) + 8 * j; const LAS float* sp = scr + (8 * c) * 33 + n;
        u32x4 o; o.x = cvt_pk_bf16(sp[0 * 33], sp[1 * 33]); o.y = cvt_pk_bf16(sp[2 * 33], sp[3 * 33]); o.z = cvt_pk_bf16(sp[4 * 33], sp[5 * 33]); o.w = cvt_pk_bf16(sp[6 * 33], sp[7 * 33]);
        *(u32x4*)(p.dst + (size_t)n * p.K + 8 * c) = o; }
    asm volatile("s_waitcnt lgkmcnt(0)" ::: "memory");
}

__device__ __forceinline__ int rel_bucket(int dist) {
    if (dist < 16) return dist;
    const float n = (float)dist;
    int large = 16 + (int)(logf(n / 16.0f) / 4.852030263919617f * 16.0f);
    return large < 31 ? large : 31;
}

typedef short v4i16_t __attribute__((ext_vector_type(4)));
constexpr int QS_STR = 144, V_STR = 160;
constexpr int LDS_Q = 0, LDS_K = LDS_Q + 128 * QS_STR, LDS_V = LDS_K + 256 * QS_STR, LDS_BT = LDS_V + 256 * V_STR, LDS_ATT_END = LDS_BT + 336 * 4;
static_assert(LDS_ATT_END <= 131072, "attention LDS");
constexpr int ATT_UNITS = 1536;
struct AItem { int g, h, dsh, n, r, first; size_t tokb; };
__device__ __forceinline__ void attn_decode(int unit, int j, AItem& a) {
    const int g = unit / 512, rem = unit % 512, b = rem / 128, rem2 = rem % 128, h = rem2 / 16, w4 = rem2 % 16;
    a.g = g; a.h = h; a.dsh = 2 * g; const int cpr = 16 >> a.dsh;
    a.r = w4 / cpr; a.n = (w4 % cpr) * 4 + j; a.first = (j == 0); a.tokb = (size_t)b * SEQ;
}
__device__ __forceinline__ void attn_fetch(const AItem& a, int tid, const bf16_t* Q, const bf16_t* Kb, const bf16_t* V, const float* biasT,
                                           u32x4 (&qv)[2], u32x4 (&kc)[2], u32x4 (&vc)[2], u32x4 (&kp)[2], u32x4 (&vp)[2], float& bt) {
    const int chunk = tid & 7;
#pragma unroll
    for (int j = 0; j < 2; ++j) { const int row = (tid >> 3) + 64 * j; const size_t tok = a.tokb + (size_t)((a.n * 128 + row) << a.dsh) + a.r; const size_t off = tok * CW + a.h * 64 + chunk * 8;
        qv[j] = *(const u32x4*)(Q + off); kc[j] = *(const u32x4*)(Kb + off); vc[j] = *(const u32x4*)(V + off); }
    if (a.first) {
#pragma unroll
        for (int j = 0; j < 2; ++j) { const int row = (tid >> 3) + 64 * j; int mk = (a.n - 1) * 128 + row; mk = mk < 0 ? 0 : mk; const size_t tok = a.tokb + (size_t)(mk << a.dsh) + a.r; const size_t off = tok * CW + a.h * 64 + chunk * 8;
            kp[j] = *(const u32x4*)(Kb + off); vp[j] = *(const u32x4*)(V + off); }
    }
    bt = biasT[(a.g * NH + a.h) * 129 + (tid < 128 ? tid : 128)];
}
__device__ __forceinline__ void attn_phase(LAS unsigned char* lds, int tid, int vcu, int G, const bf16_t* Q, const bf16_t* Kb, const bf16_t* V, bf16_t* OB, float* LSE, const float* biasT) {
    const int lane = tid & 63, w = __builtin_amdgcn_readfirstlane(tid >> 6), fr = lane & 15, fq = lane >> 4;
    u32x4 qv[2], kc[2], vc[2], kp[2], vp[2]; float bt; AItem cur, nxt;
#define ATT_BAR() asm volatile("s_waitcnt lgkmcnt(0)\n\ts_barrier" ::: "memory")
    f32x4 po[4]; float plse = 0.f; size_t ptok = 0; int pg = 0, ph = 0; bool have_prev = false;
#pragma unroll
    for (int dt = 0; dt < 4; ++dt) po[dt] = (f32x4){0.f, 0.f, 0.f, 0.f};
    const int qi = 16 * w + fr;
#define ATT_FLUSH() do { if (have_prev) { bf16_t* op_ = OB + (size_t)pg * T * CW + ptok * CW + ph * 64 + 4 * fq; \
        _Pragma("unroll") for (int dt = 0; dt < 4; ++dt) { u32x2 wv; wv.x = cvt_pk_bf16(po[dt][0], po[dt][1]); wv.y = cvt_pk_bf16(po[dt][2], po[dt][3]); *(u32x2*)(op_ + 16 * dt) = wv; } \
        if (fq == 0) LSE[(size_t)pg * T * NH + ptok * NH + ph] = plse; } } while (0)
    if (tid < 336) *(LAS float*)(lds + LDS_BT + tid * 4) = -INFINITY;
    __syncthreads();
    int unit = vcu, it = 0;
    if (unit < ATT_UNITS) { attn_decode(unit, 0, cur); attn_fetch(cur, tid, Q, Kb, V, biasT, qv, kc, vc, kp, vp, bt); }
    while (unit < ATT_UNITS) {
        const int par = it & 1;
        {
            const int chunk = tid & 7;
#pragma unroll
            for (int j = 0; j < 2; ++j) { const int row = (tid >> 3) + 64 * j;
                *(LAS u32x4*)(lds + LDS_Q + row * QS_STR + chunk * 16) = qv[j];
                *(LAS u32x4*)(lds + LDS_K + (par * 128 + row) * QS_STR + chunk * 16) = kc[j];
                *(LAS u32x4*)(lds + LDS_V + (par * 128 + row) * V_STR + chunk * 16) = vc[j]; }
            if (cur.first) {
#pragma unroll
                for (int j = 0; j < 2; ++j) { const int row = (tid >> 3) + 64 * j;
                    *(LAS u32x4*)(lds + LDS_K + ((par ^ 1) * 128 + row) * QS_STR + chunk * 16) = kp[j];
                    *(LAS u32x4*)(lds + LDS_V + ((par ^ 1) * 128 + row) * V_STR + chunk * 16) = vp[j]; }
            }
            if (tid < 129) *(LAS float*)(lds + LDS_BT + (160 + tid) * 4) = bt;
        }
        ATT_BAR();
        const int g = cur.g, h = cur.h, dsh = cur.dsh, n = cur.n, r = cur.r; const size_t tokb = cur.tokb;
        int nunit = unit, nj = (it & 3) + 1; if (nj == 4) { nj = 0; nunit += G; }
        if (nunit < ATT_UNITS) { attn_decode(nunit, nj, nxt); attn_fetch(nxt, tid, Q, Kb, V, biasT, qv, kc, vc, kp, vp, bt); cur = nxt; }
        ATT_FLUSH();
        const int kt0 = w < 6 ? w : 6, tx = par ? 0 : 8;
        bf16x8 qop[2], kop[10][2];
#pragma unroll
        for (int ks = 0; ks < 2; ++ks) qop[ks] = *(const LAS bf16x8*)(lds + LDS_Q + qi * QS_STR + (32 * ks + 8 * fq) * 2);
#pragma unroll
        for (int t = 0; t < 10; ++t)
#pragma unroll
            for (int ks = 0; ks < 2; ++ks) kop[t][ks] = *(const LAS bf16x8*)(lds + LDS_K + (16 * ((kt0 + t) ^ tx) + fr) * QS_STR + (32 * ks + 8 * fq) * 2);
        f32x4 s[10];
#pragma unroll
        for (int t = 0; t < 10; ++t) { s[t] = (f32x4){0.f, 0.f, 0.f, 0.f};
#pragma unroll
            for (int ks = 0; ks < 2; ++ks) s[t] = __builtin_amdgcn_mfma_f32_16x16x32_bf16(kop[t][ks], qop[ks], s[t], 0, 0, 0); }
        const LAS unsigned char* btb = lds + LDS_BT + 4 * (13 + qi + 128 - 16 * kt0 - 4 * fq);
        float mx = -INFINITY;
#pragma unroll
        for (int t = 0; t < 10; ++t)
#pragma unroll
            for (int e = 0; e < 4; ++e) s[t][e] += *(const LAS float*)(btb + 4 * (147 - 16 * t - e));
        if (n == 0) {
#pragma unroll
            for (int t = 0; t < 10; ++t)
#pragma unroll
                for (int e = 0; e < 4; ++e) if (16 * (kt0 + t) + 4 * fq + e < 128) s[t][e] = -INFINITY;
        }
#pragma unroll
        for (int t = 0; t < 10; ++t)
#pragma unroll
            for (int e = 0; e < 4; ++e) mx = fmaxf(mx, s[t][e]);
        mx = red4_max(mx);
        float l = 0.f;
#pragma unroll
        for (int t = 0; t < 10; ++t)
#pragma unroll
            for (int e = 0; e < 4; ++e) { const float p = __builtin_amdgcn_exp2f(s[t][e] - mx); s[t][e] = p; l += p; }
        l = red4_sum(l);
        f32x4 o[4];
#pragma unroll
        for (int dt = 0; dt < 4; ++dt) o[dt] = (f32x4){0.f, 0.f, 0.f, 0.f};
        const int tq = (lane & 15) >> 2, tp = lane & 3;
#pragma unroll
        for (int c = 0; c < 5; ++c) {
            const u32x4 pw = pack8(s[2 * c], s[2 * c + 1]); const bf16x8 pop = __builtin_bit_cast(bf16x8, pw);
            const int pt0 = (kt0 + 2 * c) ^ tx, pt1 = (kt0 + 2 * c + 1) ^ tx;
#pragma unroll
            for (int dt = 0; dt < 4; ++dt) {
                const v4i16_t lo = __builtin_amdgcn_ds_read_tr16_b64_v4i16((LAS v4i16_t*)(lds + LDS_V + (16 * pt0 + 4 * fq + tq) * V_STR + (16 * dt + 4 * tp) * 2));
                const v4i16_t hi = __builtin_amdgcn_ds_read_tr16_b64_v4i16((LAS v4i16_t*)(lds + LDS_V + (16 * pt1 + 4 * fq + tq) * V_STR + (16 * dt + 4 * tp) * 2));
                const bf16x8 vop = {lo[0], lo[1], lo[2], lo[3], hi[0], hi[1], hi[2], hi[3]};
                o[dt] = __builtin_amdgcn_mfma_f32_16x16x32_bf16(vop, pop, o[dt], 0, 0, 0);
            }
        }
        const float rl = __builtin_amdgcn_rcpf(l);
#pragma unroll
        for (int dt = 0; dt < 4; ++dt) po[dt] = o[dt] * rl;
        plse = mx + __builtin_amdgcn_logf(l);
        ptok = tokb + (size_t)((n * 128 + qi) << dsh) + r; pg = g; ph = h; have_prev = true;
        ATT_BAR();
        unit = nunit; ++it;
    }
    ATT_FLUSH();
#undef ATT_BAR
#undef ATT_FLUSH
}

constexpr size_t WS_SP8 = WS_BIAS + 65536;
#define PBF(off) ((bf16_t*)(wsp + (off)))
#define PF32(off) ((float*)(wsp + (off)))
typedef __attribute__((address_space(1))) unsigned char gchar_t;
#define PHASE_BEGIN gchar_t* wsp = (gchar_t*)args.ws; asm volatile("" : "+s"(wsp)); gchar_t* outp = (gchar_t*)args.out; asm volatile("" : "+s"(outp)); (void)outp; int bxp = blockIdx.x; asm volatile("" : "+s"(bxp)); \
    int tid; asm volatile("v_mbcnt_lo_u32_b32 %0, -1, 0\n\tv_mbcnt_hi_u32_b32 %0, -1, %0" : "=v"(tid)); tid += wave_s * 64; \
    const int vcu = (G % 8 == 0) ? (bxp % 8) * (G / 8) + bxp / 8 : bxp; (void)vcu; (void)wsp; (void)tid
#define GEMM(EPI, e, Aptr, Bptr, M_, N_, K_, lda_, ldb_, gsh, gby) do { int Ko_ = K_; asm volatile("" : "+s"(Ko_)); pg8::Gemm g_{(const bf16_t*)(Aptr), (const bf16_t*)(Bptr), M_, N_, Ko_, lda_, ldb_, gsh, gby}; \
        pg8::StaticOrder S_; S_.init(M_, N_, G, bxp); pg8::gemm_phase<EPI>(lds, tid, g_, S_, e); } while (0)

#define XB_TMO      128
#define XB_XCNT(j)  (256  + 64 * (j))
#define XB_XSUB(j)  (1280 + 64 * (j))
#define XB_XGEN(j)  (2304 + 64 * (j))
#define XB_TOP      3328
#define XB_TOPGEN   3392
#define XCD_BAR_WORDS 3456
#define XB_SPIN_CAP (1u << 22)
__device__ __forceinline__ unsigned xb_ld(unsigned* p)              { return __hip_atomic_load(p, __ATOMIC_RELAXED, __HIP_MEMORY_SCOPE_AGENT); }
__device__ __forceinline__ unsigned xb_add(unsigned* p, unsigned v) { return __hip_atomic_fetch_add(p, v, __ATOMIC_RELAXED, __HIP_MEMORY_SCOPE_AGENT); }
__device__ __forceinline__ unsigned xb_xcc_id() { return (unsigned)__builtin_amdgcn_s_getreg((3 << 11) | 20) & 0xFu; }
#define XB_SPIN(cond, bar) do { unsigned _sp = 0; while (cond) { __builtin_amdgcn_s_sleep(1); \
    if ((++_sp & 255u) == 0u) { if (xb_ld(&(bar)[XB_TMO])) break; if (_sp > XB_SPIN_CAP) { atomicAdd(&(bar)[XB_TMO], 1u); break; } } } } while (0)
__device__ __forceinline__ bool is_leader(int wave_s) { int lane; asm volatile("v_mbcnt_lo_u32_b32 %0, -1, 0\n\tv_mbcnt_hi_u32_b32 %0, -1, %0" : "=v"(lane)); return wave_s == 0 && lane == 0; }
__device__ __forceinline__ void xcd_barrier_complete(unsigned* bar, unsigned x, unsigned G, unsigned& nloc, unsigned& nx) {
    unsigned sum, cnt, mine, sp = 0u;
    for (;;) {
        sum = 0u; cnt = 0u; mine = 0u;
#pragma unroll
        for (unsigned j = 0; j < 16; ++j) { const unsigned c = xb_ld(&bar[XB_XCNT(j)]); sum += c; cnt += (c > 0u) ? 1u : 0u; mine = (j == x) ? c : mine; }
        if (sum == G) break;
        __builtin_amdgcn_s_sleep(1);
        if ((++sp & 255u) == 0u) { if (xb_ld(&bar[XB_TMO])) break; if (sp > XB_SPIN_CAP) { atomicAdd(&bar[XB_TMO], 1u); break; } }
    }
    nloc = mine > 0u ? mine : 1u; nx = cnt > 0u ? cnt : 1u;
}
__device__ __forceinline__ void grid_bar(unsigned* bar, volatile LAS unsigned* st, int wave_s, unsigned G) {
    asm volatile("s_waitcnt vmcnt(0) lgkmcnt(0)" ::: "memory");
    __syncthreads();
    if (is_leader(wave_s)) {
        const unsigned x = xb_xcc_id();
        unsigned nloc = st[0], nx = st[1];
        if (nloc == 0u) { xcd_barrier_complete(bar, x, G, nloc, nx); st[0] = nloc; st[1] = nx; }
        const unsigned old = xb_add(&bar[XB_XSUB(x)], 1u);
        const unsigned gen = old / nloc;
        if (old + 1u == (gen + 1u) * nloc) {
            __builtin_amdgcn_fence(__ATOMIC_RELEASE, "agent");
            asm volatile("s_waitcnt vmcnt(0)" ::: "memory");
            const unsigned og = xb_add(&bar[XB_TOP], 1u);
            const unsigned tg = og / nx;
            if (og + 1u == (tg + 1u) * nx) xb_add(&bar[XB_TOPGEN], 1u);
            else XB_SPIN(xb_ld(&bar[XB_TOPGEN]) == tg, bar);
            __builtin_amdgcn_fence(__ATOMIC_ACQUIRE, "agent");
            asm volatile("s_waitcnt vmcnt(0)" ::: "memory");
        } else {
            XB_SPIN(xb_ld(&bar[XB_TOPGEN]) == gen, bar);
            __builtin_amdgcn_fence(__ATOMIC_ACQUIRE, "agent");
            asm volatile("s_waitcnt vmcnt(0)" ::: "memory");
        }
    }
    __syncthreads();
}
__device__ __forceinline__ bool phase_in(int lo, int hi, int k) { asm volatile("" : "+s"(lo), "+s"(hi)); return lo <= k && k < hi; }
#ifndef PHMASK
#define PHMASK 0xffffffffu
#endif
#define IN(k) (((PHMASK >> (k)) & 1u) && phase_in(lo, hi, (k)))
#ifndef DUPMASK
#define DUPMASK 0u
#endif
#if DUPMASK
#ifndef DUPN
#define DUPN 1
#endif
__device__ __forceinline__ int phase_rep(int k) { int r = ((DUPMASK >> k) & 1u) ? 1 + DUPN : 1; asm volatile("" : "+s"(r)); return r; }
#define REP(k) for (int rep_ = 0, nrep_ = phase_rep(k); rep_ < nrep_; ++rep_)
#else
#define REP(k)
#endif
#ifndef DUPBAR
#define DUPBAR 1
#endif
#define SEAM(k) do { if (IN(k) && IN((k) + 1)) { for (int b_ = 0; b_ < DUPBAR; ++b_) grid_bar((unsigned*)args.ws, (volatile LAS unsigned*)(lds + 131072), wave_s, (unsigned)G); } } while (0)
template <int L> __device__ __forceinline__ void layer_body(const Args& args, LAS unsigned char* lds, const int G, const int lo, const int hi, const int wave_s, unsigned& nbar) {

        const size_t hbc_off = L == 0 ? WS_HB0 : WS_HB1;
        const int P_GU1 = L == 0 ? 1 : 10, P_DN1 = P_GU1 + 1;
        if (IN(P_GU1)) REP(P_GU1) { PHASE_BEGIN; EpiGU e{PF32(WS_SS0), PBF(WS_ACT)}; GEMM(EpiGU, e, wsp + hbc_off, wsp + W_GU + (size_t)(L * 2 + 0) * 11 * MiB, T, 2 * FF, D, D, D, 31, 0); }
        SEAM(P_GU1);
        if (IN(P_DN1)) REP(P_DN1) { PHASE_BEGIN; typedef EpiRes<L == 0> EpiR; EpiR e{L == 0 ? (const void*)args.in[0] : (const void*)PBF(hbc_off), PBF(hbc_off), PF32(WS_SS1), 0.5f}; GEMM(EpiR, e, wsp + WS_ACT, wsp + W_DN + (size_t)(L * 2 + 0) * 11 * MiB / 2, T, D, FF, FF, FF, 31, 0); }
        SEAM(P_DN1);
        if constexpr (L == 0) {
            constexpr size_t O_GB = WS_ACT, O_U = WS_ACT + (size_t)T * CW * 2, O_Q = WS_ACT + (size_t)2 * T * CW * 2, O_K = WS_ACT + (size_t)3 * T * CW * 2, O_V = WS_ACT + (size_t)4 * T * CW * 2;
            constexpr size_t O_YC = O_Q;
            if (IN(3)) REP(3) { PHASE_BEGIN; EpiHin e{PF32(WS_SS1), PBF(O_GB), PBF(O_U), PBF(O_Q), PBF(O_K), PBF(O_V), args.in[10], args.in[11]}; GEMM(EpiHin, e, wsp + WS_HB0, wsp + W_HIN, T, 3072, D, D, D, 31, 0); }
            SEAM(3);
            if (IN(4)) REP(4) { PHASE_BEGIN; attn_phase(lds, tid, vcu, G, PBF(O_Q), PBF(O_K), PBF(O_V), (bf16_t*)outp, PF32(WS_LSE), PF32(WS_BIAS)); }
            SEAM(4);
            if (IN(5)) REP(5) {
                PHASE_BEGIN;
                const float* cw = args.in[9]; const bf16_t *GB = PBF(O_GB), *U = PBF(O_U), *OB = (const bf16_t*)outp; bf16_t* YC = PBF(O_YC); const float* LSE = PF32(WS_LSE);
                const int c8 = (tid & 127) * 8; const int tstride = G * 4;
                if (c8 < CW) {
                    f32x4 wt[3][2];
#pragma unroll
                    for (int j = 0; j < 3; ++j) { wt[j][0] = *(const f32x4*)(cw + j * CW + c8); wt[j][1] = *(const f32x4*)(cw + j * CW + c8 + 4); }
                    for (int tb = vcu * 4 + (tid >> 7); tb < T; tb += 4 * tstride) {
                        u32x4 uw[4][3], gw_[4];
#pragma unroll
                        for (int q = 0; q < 4; ++q) { const int t = tb + q * tstride, sp = t & (SEQ - 1); if (t < T) {
#pragma unroll
                            for (int j = 0; j < 3; ++j) { const int back = 2 - j; uw[q][j] = (sp - back >= 0) ? *(const u32x4*)(U + (size_t)(t - back) * CW + c8) : (u32x4){0u, 0u, 0u, 0u}; }
                            gw_[q] = *(const u32x4*)(GB + (size_t)t * CW + c8); } }
#pragma unroll
                        for (int q = 0; q < 4; ++q) { const int t = tb + q * tstride; if (t < T) {
                            f32x4 y0 = {0.f, 0.f, 0.f, 0.f}, y1 = y0;
#pragma unroll
                            for (int j = 0; j < 3; ++j) { y0 += wt[j][0] * bf4_lo(uw[q][j]); y1 += wt[j][1] * bf4_hi(uw[q][j]); }
                            y0 *= bf4_lo(gw_[q]); y1 *= bf4_hi(gw_[q]);
                            *(u32x4*)(YC + (size_t)t * D + c8) = pack8(y0, y1); } }
                    }
                } else {
                    const int ch = c8 - CW, hd = ch >> 6;
                    for (int tb = vcu * 4 + (tid >> 7); tb < T; tb += 4 * tstride) {
                        u32x4 ow[4][3]; float lv[4][3];
#pragma unroll
                        for (int q = 0; q < 4; ++q) { const int t = tb + q * tstride; if (t < T) {
#pragma unroll
                            for (int g = 0; g < 3; ++g) { lv[q][g] = LSE[(size_t)g * T * NH + (size_t)t * NH + hd]; ow[q][g] = *(const u32x4*)(OB + (size_t)g * T * CW + (size_t)t * CW + ch); } } }
#pragma unroll
                        for (int q = 0; q < 4; ++q) { const int t = tb + q * tstride; if (t < T) {
                            const float mxl = fmaxf(lv[q][0], fmaxf(lv[q][1], lv[q][2]));
                            float w0 = __builtin_amdgcn_exp2f(lv[q][0] - mxl), w1 = __builtin_amdgcn_exp2f(lv[q][1] - mxl), w2 = __builtin_amdgcn_exp2f(lv[q][2] - mxl);
                            const float inv = __builtin_amdgcn_rcpf(w0 + w1 + w2); w0 *= inv; w1 *= inv; w2 *= inv;
                            const f32x4 y0 = bf4_lo(ow[q][0]) * w0 + bf4_lo(ow[q][1]) * w1 + bf4_lo(ow[q][2]) * w2, y1 = bf4_hi(ow[q][0]) * w0 + bf4_hi(ow[q][1]) * w1 + bf4_hi(ow[q][2]) * w2;
                            *(u32x4*)(YC + (size_t)t * D + c8) = pack8(y0, y1); } }
                    }
                }
            }
            SEAM(5);
            if (IN(6)) REP(6) { PHASE_BEGIN; typedef EpiRes<false> EpiR; EpiR e{PBF(WS_HB0), PBF(WS_HB0), PF32(WS_SS0), 1.0f}; GEMM(EpiR, e, wsp + O_YC, wsp + W_HOUT, T, D, D, D, D, 31, 0); }
            SEAM(6);
        } else {
            constexpr size_t O_XB = WS_HB0, O_GY = WS_PP, O_AA = WS_ACT;
#define XC_P ((bf16_t*)outp)
#define UU_P ((bf16_t*)(outp + 64 * MiB))
#define YR_P ((bf16_t*)outp)
            if (IN(12)) REP(12) { PHASE_BEGIN; EpiRin e{PF32(WS_SS1), PBF(O_XB), PBF(O_GY)}; GEMM(EpiRin, e, wsp + WS_HB1, wsp + W_RIN, T, 2048, D, D, D, 31, 0); }
            SEAM(12);
            if (IN(13)) REP(13) {
                PHASE_BEGIN;
                const float* cw = args.in[14]; const float* cb = args.in[15]; const bf16_t* XB = PBF(O_XB); bf16_t* XC = XC_P;
                const int c8 = (tid & 127) * 8; const int tstride = G * 4;
                f32x4 wt[4][2], bs[2];
#pragma unroll
                for (int j = 0; j < 4; ++j) { wt[j][0] = *(const f32x4*)(cw + j * D + c8); wt[j][1] = *(const f32x4*)(cw + j * D + c8 + 4); }
                bs[0] = *(const f32x4*)(cb + c8); bs[1] = *(const f32x4*)(cb + c8 + 4);
                for (int tb = vcu * 4 + (tid >> 7); tb < T; tb += 4 * tstride) {
                    u32x4 xw[4][4];
#pragma unroll
                    for (int q = 0; q < 4; ++q) { const int t = tb + q * tstride, sp = t & (SEQ - 1); if (t < T) {
#pragma unroll
                        for (int j = 0; j < 4; ++j) { const int back = 3 - j; xw[q][j] = (sp - back >= 0) ? *(const u32x4*)(XB + (size_t)(t - back) * D + c8) : (u32x4){0u, 0u, 0u, 0u}; } } }
#pragma unroll
                    for (int q = 0; q < 4; ++q) { const int t = tb + q * tstride; if (t < T) {
                        f32x4 y0 = bs[0], y1 = bs[1];
#pragma unroll
                        for (int j = 0; j < 4; ++j) { y0 += wt[j][0] * bf4_lo(xw[q][j]); y1 += wt[j][1] * bf4_hi(xw[q][j]); }
                        *(u32x4*)(XC + (size_t)t * D + c8) = pack8(y0, y1); } }
                }
            }
            SEAM(13);
            if (IN(14)) REP(14) { PHASE_BEGIN; EpiGates e{XC_P, args.in[17], args.in[19], PF32(WS_SP8), PBF(O_AA), UU_P}; GEMM(EpiGates, e, XC_P, wsp + W_LRU, T, 2048, 256, D, 256, 1, 512); }
            SEAM(14);
            if (IN(15)) REP(15) {
                PHASE_BEGIN; const bf16_t* LA = PBF(O_AA); const bf16_t* UU = UU_P; float* AGG = PF32(WS_AGG);
                for (int item = vcu; item < NBATCH * 64; item += G) {
                    const size_t t0 = (size_t)item * 128; f32x2 Ls = {0.f, 0.f}, Up = {0.f, 0.f};
                    unsigned lw[2][16], uw[2][16];
#pragma unroll
                    for (int t = 0; t < 16; ++t) { lw[0][t] = *(const unsigned*)(LA + (t0 + t) * D + 2 * tid); uw[0][t] = *(const unsigned*)(UU + (t0 + t) * D + 2 * tid); }
#pragma unroll
                    for (int tbi = 0; tbi < 8; ++tbi) { const int cb = tbi & 1, nb = cb ^ 1;
                        if (tbi < 7) {
#pragma unroll
                            for (int t = 0; t < 16; ++t) { lw[nb][t] = *(const unsigned*)(LA + (t0 + (tbi + 1) * 16 + t) * D + 2 * tid); uw[nb][t] = *(const unsigned*)(UU + (t0 + (tbi + 1) * 16 + t) * D + 2 * tid); } }
#pragma unroll
                        for (int t = 0; t < 16; ++t) { const f32x2 l2 = {bf_lo(lw[cb][t]), bf_hi(lw[cb][t])}; const f32x2 a = {__builtin_amdgcn_exp2f(l2[0]), __builtin_amdgcn_exp2f(l2[1])};
                            Ls += l2; Up = a * Up + (f32x2){bf_lo(uw[cb][t]), bf_hi(uw[cb][t])}; }
                        asm volatile("" ::: "memory"); }
                    *(f32x4*)(AGG + ((size_t)item * D + 2 * tid) * 2) = (f32x4){__builtin_amdgcn_exp2f(Ls[0]), __builtin_amdgcn_exp2f(Ls[1]), Up[0], Up[1]};
                }
            }
            SEAM(15);
            if (IN(16)) REP(16) {
                PHASE_BEGIN; const bf16_t* LA = PBF(O_AA); const bf16_t* UU = UU_P; const float* AGG = PF32(WS_AGG); const bf16_t* GY = PBF(O_GY); bf16_t* YR = YR_P;
                for (int item = vcu; item < NBATCH * 64; item += G) {
                    const int b = item >> 6, k = item & 63; const size_t t0 = (size_t)item * 128; f32x2 hs = {0.f, 0.f};
                    unsigned lw[2][16], uw[2][16], gw_[2][16];
#pragma unroll
                    for (int t = 0; t < 16; ++t) { lw[0][t] = *(const unsigned*)(LA + (t0 + t) * D + 2 * tid); uw[0][t] = *(const unsigned*)(UU + (t0 + t) * D + 2 * tid); gw_[0][t] = *(const unsigned*)(GY + (t0 + t) * D + 2 * tid); }
#pragma unroll 1
                    for (int jb = 0; jb < 64; jb += 8) { if (jb >= k) break; f32x4 au[8];
#pragma unroll
                        for (int j = 0; j < 8; ++j) au[j] = *(const f32x4*)(AGG + ((size_t)(b * 64 + jb + j) * D + 2 * tid) * 2);
#pragma unroll
                        for (int j = 0; j < 8; ++j) if (jb + j < k) hs = (f32x2){au[j][0], au[j][1]} * hs + (f32x2){au[j][2], au[j][3]}; }
#pragma unroll
                    for (int tbi = 0; tbi < 8; ++tbi) { const int cb = tbi & 1, nb = cb ^ 1;
                        if (tbi < 7) {
#pragma unroll
                            for (int t = 0; t < 16; ++t) { const size_t o_ = (t0 + (tbi + 1) * 16 + t) * D + 2 * tid; lw[nb][t] = *(const unsigned*)(LA + o_); uw[nb][t] = *(const unsigned*)(UU + o_); gw_[nb][t] = *(const unsigned*)(GY + o_); } }
#pragma unroll
                        for (int t = 0; t < 16; ++t) { const f32x2 a = {__builtin_amdgcn_exp2f(bf_lo(lw[cb][t])), __builtin_amdgcn_exp2f(bf_hi(lw[cb][t]))}; hs = a * hs + (f32x2){bf_lo(uw[cb][t]), bf_hi(uw[cb][t])};
                            *(unsigned*)(YR + (t0 + tbi * 16 + t) * D + 2 * tid) = cvt_pk_bf16(hs[0] * bf_lo(gw_[cb][t]), hs[1] * bf_hi(gw_[cb][t])); }
                        asm volatile("" ::: "memory"); }
                }
            }
            SEAM(16);
            if (IN(17)) REP(17) { PHASE_BEGIN; typedef EpiRes<false> EpiR; EpiR e{PBF(WS_HB1), PBF(WS_HB0), PF32(WS_SS0), 1.0f}; GEMM(EpiR, e, YR_P, wsp + W_ROUT, T, D, D, D, D, 31, 0); }
            SEAM(17);
        }
        const int P_GU2 = L == 0 ? 7 : 18, P_DN2 = P_GU2 + 1, P_PP = P_GU2 + 2, P_PLE = P_GU2 + 3;
        if (IN(P_GU2)) REP(P_GU2) { PHASE_BEGIN; EpiGU e{PF32(WS_SS0), PBF(WS_ACT)}; GEMM(EpiGU, e, wsp + WS_HB0, wsp + W_GU + (size_t)(L * 2 + 1) * 11 * MiB, T, 2 * FF, D, D, D, 31, 0); }
        SEAM(P_GU2);
        if (IN(P_DN2)) REP(P_DN2) { PHASE_BEGIN; typedef EpiRes<false> EpiR; EpiR e{PBF(WS_HB0), PBF(WS_HB0), PF32(WS_SS1), 0.5f}; GEMM(EpiR, e, wsp + WS_ACT, wsp + W_DN + (size_t)(L * 2 + 1) * 11 * MiB / 2, T, D, FF, FF, FF, 31, 0); }
        if (IN(P_DN2)) REP(21) { PHASE_BEGIN; EpiPlain e{PBF(WS_PP)}; GEMM(EpiPlain, e, wsp + WS_PB + (size_t)L * T * PLE * 2, wsp + W_PPW + (size_t)L * MiB / 2, T, D, PLE, PLE, PLE, 31, 0); }
        SEAM(P_DN2);
        (void)P_PP;
        if (IN(P_DN2 + 1)) REP(P_DN2 + 1) { PHASE_BEGIN; typedef EpiPle<L == 1> EpiP; EpiP e{PF32(WS_SS1), PBF(WS_PP), PBF(WS_HB0), args.out, PBF(WS_HB1), PF32(WS_SS0)}; GEMM(EpiP, e, wsp + WS_HB0, wsp + W_PG + (size_t)L * 2 * MiB, T, D, D, D, D, 31, 0); }
        (void)P_PLE;
        if (L == 0) SEAM(9);

}
__global__ void __launch_bounds__(512, 2) mk_fwd(Args args) {
    extern __shared__ __attribute__((aligned(16))) unsigned char lds_raw[];
    LAS unsigned char* lds = (LAS unsigned char*)lds_raw;
    const int G = gridDim.x;
    const int wave_s = __builtin_amdgcn_readfirstlane(threadIdx.x >> 6);
    const int lo = args.ph_lo, hi = args.ph_hi;
    if (threadIdx.x < 16) ((LAS unsigned*)(lds + 131072))[threadIdx.x] = 0u;
    if (hi - lo > 1) {
        if (threadIdx.x == 0) (void)xb_add(&((unsigned*)args.ws)[XB_XCNT(xb_xcc_id())], 1u);
        cg::this_grid().sync();
    }
    __syncthreads();

    unsigned nbar = 0;
    if (IN(0)) REP(0) {
        PHASE_BEGIN;
        const int lane = tid & 63, wave = __builtin_amdgcn_readfirstlane(tid >> 6);
        LAS float* scr = (LAS float*)(lds + wave * 16384);
        const int gw = vcu * 8 + wave, NGW = G * 8;
        {
            P0Item pc, pn; int Nc = 0, Nn = 0; f32x4 v[8], vn[8]; float gk[8], gkn[8];
            int it = gw;
            if (it < args.nitems) { p0_decode(args, it, pc, Nc); p0_load(pc, Nc, lane, v, gk); }
            for (; it < args.nitems; it += NGW) {
                const bool more = it + NGW < args.nitems;
                if (more) { p0_decode(args, it + NGW, pn, Nn); p0_load(pn, Nn, lane, vn, gkn); }
                p0_emit(pc, scr, lane, v, gk);
                if (more) { pc = pn; Nc = Nn;
#pragma unroll
                    for (int i = 0; i < 8; ++i) { v[i] = vn[i]; gk[i] = gkn[i]; } }
            }
        }
        const float* x = args.in[0]; bf16_t* HB0 = PBF(WS_HB0); float* SS0 = PF32(WS_SS0);
        for (int m0 = gw * 4; m0 < T; m0 += NGW * 4) {
            f32x4 v[4][4]; float sq[4];
#pragma unroll
            for (int r = 0; r < 4; ++r) { const f32x4* xr = (const f32x4*)(x + (size_t)(m0 + r) * D) + lane;
#pragma unroll
                for (int j = 0; j < 4; ++j) v[r][j] = xr[64 * j]; }
#pragma unroll
            for (int r = 0; r < 4; ++r) { float s_ = 0.f;
#pragma unroll
                for (int j = 0; j < 4; ++j) s_ += (v[r][j][0] * v[r][j][0] + v[r][j][1] * v[r][j][1]) + (v[r][j][2] * v[r][j][2] + v[r][j][3] * v[r][j][3]);
                sq[r] = wave_sum(s_);
                u32x2* o8 = (u32x2*)(HB0 + (size_t)(m0 + r) * D) + lane;
#pragma unroll
                for (int j = 0; j < 4; ++j) { u32x2 wv; wv.x = cvt_pk_bf16(v[r][j][0], v[r][j][1]); wv.y = cvt_pk_bf16(v[r][j][2], v[r][j][3]); o8[64 * j] = wv; } }
            { const int r = lane >> 4, c = lane & 15; const float sv = r == 0 ? sq[0] : r == 1 ? sq[1] : r == 2 ? sq[2] : sq[3]; SS0[(size_t)(m0 + r) * 16 + c] = c == 0 ? sv : 0.f; }
        }
        const float* p = args.in[1]; bf16_t* PB = PBF(WS_PB);
        { const size_t NV = (size_t)2 * T * PLE / 8, st = (size_t)G * 512;
            for (size_t i = (size_t)(vcu * 512 + tid); i < NV; i += 4 * st) {
                f32x4 a[4], b[4];
#pragma unroll
                for (int q = 0; q < 4; ++q) if (i + q * st < NV) { a[q] = *(const f32x4*)(p + (i + q * st) * 8); b[q] = *(const f32x4*)(p + (i + q * st) * 8 + 4); }
#pragma unroll
                for (int q = 0; q < 4; ++q) if (i + q * st < NV) *(u32x4*)(PB + (i + q * st) * 8) = pack8(a[q], b[q]);
            } }
        if (bxp == 0) { const float* rb = args.in[2]; float* BIAS = PF32(WS_BIAS);
            for (int i = tid; i < 3 * NH * 129; i += 512) { const int g = i / (NH * 129), h = (i / 129) % NH, dist = i % 129; BIAS[i] = rb[rel_bucket(dist << (2 * g)) * NH + h] * LOG2E; } }
        if (bxp == 1) { const float* lam = args.in[20]; float* SP8 = PF32(WS_SP8);
            for (int i = tid; i < D; i += 512) SP8[i] = 8.0f * log1pf(expf(-lam[i])); }
    }
    SEAM(0);

    layer_body<0>(args, lds, G, lo, hi, wave_s, nbar);
    layer_body<1>(args, lds, G, lo, hi, wave_s, nbar);
}
#undef IN
#undef SEAM


extern "C" void kernel_launch(void* const* d_in, const int* in_sizes, int n_in, void* d_out, int out_size, void* d_ws, size_t ws_size, hipStream_t stream) {
    static int grid = 0;
    if (grid == 0) {
        if (n_in != 29 || out_size != T * D || ws_size < WS_END) { fprintf(stderr, "kernel_launch: unexpected shapes (n_in %d, out %d, ws %zu)\n", n_in, out_size, ws_size); grid = -1; return; }
        int dev = 0, cus = 0, per_cu = 0;
        hipGetDevice(&dev); hipDeviceGetAttribute(&cus, hipDeviceAttributeMultiprocessorCount, dev);
        hipFuncSetAttribute((const void*)mk_fwd, hipFuncAttributeMaxDynamicSharedMemorySize, LDS_BYTES);
        hipOccupancyMaxActiveBlocksPerMultiprocessor(&per_cu, (const void*)mk_fwd, 512, LDS_BYTES);
        if (per_cu < 1) { fprintf(stderr, "kernel_launch: occupancy query says %d blocks per CU\n", per_cu); per_cu = 1; }
        (void)hipGetLastError();
        grid = cus;
    }
    if (grid < 0) return;
    Args a{};
    for (int i = 0; i < 29; ++i) a.in[i] = (const float*)d_in[i];
    a.out = (float*)d_out; a.ws = (unsigned char*)d_ws;
    unsigned char* ws = (unsigned char*)d_ws;
    int nj = 0, start = 0;
    auto add = [&](const float* W, const float* gain, size_t wt_off, int K, int N, int mode, int row_base) {
        Job& j = a.jobs[nj++]; j.W = W; j.gain = gain; j.WT = (bf16_t*)(ws + wt_off); j.K = K; j.N = N; j.mode = mode; j.row_base = row_base; j.start = start; j.pad = 0; start += (K / 64) * (N / 32); };
    const float* const* in = a.in;
    for (int l = 0; l < 2; ++l) {
        for (int f = 0; f < 2; ++f) {
            const float* nrm = in[f == 0 ? 3 : 22] + (size_t)l * D; const float* wg = in[f == 0 ? 4 : 23] + (size_t)l * D * FF; const float* wu = in[f == 0 ? 5 : 24] + (size_t)l * D * FF; const float* wd = in[f == 0 ? 6 : 25] + (size_t)l * D * FF;
            add(wg, nrm, W_GU + (size_t)(l * 2 + f) * 11 * MiB, D, FF, 1, 0);
            add(wu, nrm, W_GU + (size_t)(l * 2 + f) * 11 * MiB, D, FF, 2, 0);
            add(wd, nullptr, W_DN + (size_t)(l * 2 + f) * 11 * MiB / 2, FF, D, 0, 0);
        }
    }
    add(in[8], in[7], W_HIN, D, 3072, 4, 0);
    add(in[12], nullptr, W_HOUT, D, D, 0, 0);
    add(in[13], in[7] + D, W_RIN, D, 2048, 0, 0);
    for (int g = 0; g < 4; ++g) { add(in[16] + (size_t)g * 65536, nullptr, W_LRU, 256, 256, 1, g * 512); add(in[18] + (size_t)g * 65536, nullptr, W_LRU, 256, 256, 2, g * 512); }
    add(in[21], nullptr, W_ROUT, D, D, 0, 0);
    for (int l = 0; l < 2; ++l) { add(in[27] + (size_t)l * D * D, in[26] + (size_t)l * D, W_PG + (size_t)l * 2 * MiB, D, D, 0, 0); add(in[28] + (size_t)l * PLE * D, nullptr, W_PPW + (size_t)l * MiB / 2, PLE, D, 0, 0); }
    a.nitems = start;
    if (nj != NJOBS) { fprintf(stderr, "kernel_launch: job count %d != %d\n", nj, NJOBS); return; }
#if MK_MULTI
    for (int ph = 0; ph < NPHASE; ++ph) { a.ph_lo = ph; a.ph_hi = ph + 1; hipLaunchKernelGGL(mk_fwd, dim3(grid), dim3(512), LDS_BYTES, stream, a); }
#else
    a.ph_lo = 0; a.ph_hi = NPHASE;
    if (hipMemsetAsync(d_ws, 0, XCD_BAR_WORDS * 4, stream) != hipSuccess) { fprintf(stderr, "kernel_launch: memset failed\n"); return; }
    void* kargs[] = {&a};
    hipError_t e = hipLaunchCooperativeKernel((const void*)mk_fwd, dim3(grid), dim3(512), kargs, LDS_BYTES, stream);
    if (e != hipSuccess) fprintf(stderr, "kernel_launch: cooperative launch failed: %s (grid %d)\n", hipGetErrorString(e), grid);
#endif
}
```

```cpp
#include <hip/hip_runtime.h>
#include <hip/hip_cooperative_groups.h>
#include <cstdio>
#include <cstdint>
namespace cg = cooperative_groups;

#define LAS __attribute__((address_space(3)))
typedef unsigned short bf16_t;
typedef short bf16x8 __attribute__((ext_vector_type(8)));
typedef short s16x4 __attribute__((ext_vector_type(4)));
typedef float f32x4 __attribute__((ext_vector_type(4)));
typedef float f32x2 __attribute__((ext_vector_type(2)));
typedef unsigned u32x4 __attribute__((ext_vector_type(4)));
typedef unsigned u32x2 __attribute__((ext_vector_type(2)));

#ifndef MK_MULTI
#define MK_MULTI 0
#endif

constexpr int NBATCH = 4, SEQ = 8192, T = NBATCH * SEQ, D = 1024, FF = 2816, NH = 8, HD = 64, CW = 512, PLE = 256;
constexpr float EPS = 1e-6f;
constexpr float LOG2E = 1.4426950408889634f;
constexpr float QSCALE = 0.125f * LOG2E;
constexpr int NPHASE = 21;

constexpr size_t MiB = 1u << 20;
constexpr size_t WS_WTS = 1 * MiB;
constexpr size_t WS_HB0 = 97 * MiB, WS_HB1 = 161 * MiB, WS_ACT = 225 * MiB, WS_PP = 401 * MiB, WS_PB = 465 * MiB;
constexpr size_t WS_SS0 = 497 * MiB, WS_SS1 = 499 * MiB, WS_LSE = 501 * MiB, WS_AGG = 504 * MiB, WS_BIAS = 506 * MiB, WS_END = 512 * MiB;
constexpr size_t W_GU = WS_WTS;
constexpr size_t W_DN = W_GU + 44 * MiB;
constexpr size_t W_HIN = W_DN + 22 * MiB;
constexpr size_t W_HOUT = W_HIN + 6 * MiB;
constexpr size_t W_RIN = W_HOUT + 2 * MiB;
constexpr size_t W_LRU = W_RIN + 4 * MiB;
constexpr size_t W_ROUT = W_LRU + 1 * MiB;
constexpr size_t W_PG = W_ROUT + 2 * MiB;
constexpr size_t W_PPW = W_PG + 4 * MiB;
static_assert(W_PPW + 1 * MiB <= WS_HB0, "weights fit");

__device__ __forceinline__ unsigned cvt_pk_bf16(float lo, float hi) { unsigned r; asm volatile("v_cvt_pk_bf16_f32 %0, %1, %2" : "=v"(r) : "v"(lo), "v"(hi)); return r; }
__device__ __forceinline__ float bf_lo(unsigned w) { return __uint_as_float(w << 16); }
__device__ __forceinline__ float bf_hi(unsigned w) { return __uint_as_float(w & 0xffff0000u); }
__device__ __forceinline__ float fast_sigmoid(float x) { return __builtin_amdgcn_rcpf(1.0f + __builtin_amdgcn_exp2f(-x * LOG2E)); }
__device__ __forceinline__ float red4_sum(float x) {
    auto r = __builtin_amdgcn_permlane16_swap(__float_as_uint(x), __float_as_uint(x), false, false); x = __uint_as_float(r[0]) + __uint_as_float(r[1]);
    auto q = __builtin_amdgcn_permlane32_swap(__float_as_uint(x), __float_as_uint(x), false, false); return __uint_as_float(q[0]) + __uint_as_float(q[1]);
}
__device__ __forceinline__ float red4_max(float x) {
    auto r = __builtin_amdgcn_permlane16_swap(__float_as_uint(x), __float_as_uint(x), false, false); x = fmaxf(__uint_as_float(r[0]), __uint_as_float(r[1]));
    auto q = __builtin_amdgcn_permlane32_swap(__float_as_uint(x), __float_as_uint(x), false, false); return fmaxf(__uint_as_float(q[0]), __uint_as_float(q[1]));
}
__device__ __forceinline__ float wave_sum(float v) {
#pragma unroll
    for (int o = 1; o < 64; o <<= 1) v += __shfl_xor(v, o);
    return v;
}

constexpr int RS_OFF = 131072 + 2048;
namespace pg8 {
constexpr int BM = 256, BK = 64, HALF = 128, HTB = HALF * BK * 2, STAGE_BYTES = 8 * HTB, NXCD = 8, WGM = 8;
__host__ __device__ __forceinline__ int lds_byte(int r, int c) { const int st = (r >> 4) * 2 + (c >> 5), rr = r & 15, cc = c & 31, ob = rr * 64 + cc * 2; return st * 1024 + (ob ^ (((ob >> 9) & 1) << 5)); }
__host__ __device__ __forceinline__ void stage_rc(int b, int& R, int& C) { const int st = b / 1024, sb = b % 1024, swz = sb ^ (((sb >> 9) & 1) << 5); R = (st >> 1) * 16 + swz / 64; C = (st & 1) * 32 + (swz % 64) / 2; }
__host__ __device__ __forceinline__ int perm32(int rho) { const int n = rho >> 4, i = rho & 15; return 8 * (i >> 2) + 4 * n + (i & 3); }

struct Unit { int pm, pn; };
struct Gemm { const bf16_t* A; const bf16_t* Bt; int M, N, K, lda, ldb, a_grp_shift, a_grp_bytes; };

struct StaticOrder {
    int nM, nN, nwg, G, c;
    __device__ void init(int M, int N, int G_, int c_) { nM = M / BM; nN = N / BM; nwg = nM * nN; G = G_; c = c_; }
    __device__ bool next(int i, Unit& u) const {
        const long L = (long)i * G + c; if (L >= nwg) return false;
        int wgid = (int)L; { const int q = nwg / NXCD, r = nwg % NXCD, xcd = wgid % NXCD, off = wgid / NXCD; wgid = (xcd < r ? xcd * (q + 1) : r * (q + 1) + (xcd - r) * q) + off; }
        const int nig = WGM * nN, gid = wgid / nig, fm = gid * WGM, gsz = (nM - fm) < WGM ? (nM - fm) : WGM;
        u.pm = fm + ((wgid % nig) % gsz); u.pn = (wgid % nig) / gsz; return true;
    }
};

template <class Epi>
__device__ __forceinline__ void gemm_phase(LAS unsigned char* lds, const int tid, const Gemm g, const StaticOrder& S, const Epi& E) {
    const int wid = __builtin_amdgcn_readfirstlane(tid >> 6), lane = tid & 63, wr = wid >> 2, wc = wid & 3, fr = lane & 15, fq = lane >> 4;
    const int K = g.K, nt = K / BK;
    unsigned voffA[2], voffB[2];
#pragma unroll
    for (int i = 0; i < 2; ++i) { int R, C; stage_rc(tid * 16 + i * 8192, R, C); const int Rb = (R & ~31) + perm32(R & 31);
        voffA[i] = (unsigned)(R * g.lda + C) * 2u; voffB[i] = (unsigned)(Rb * g.ldb + C) * 2u; }
    const size_t kstep = (size_t)(BK * 2);
    const size_t hstepA = (size_t)HALF * g.lda * 2, hstepB = (size_t)HALF * g.ldb * 2;
    const size_t tstepA = 2 * hstepA, tstepB = 2 * hstepB;
    const unsigned ldsw = (unsigned)wid * 1024u;
    const int aoff = lds_byte(wr * 64 + fr, fq * 8), boff = lds_byte(wc * 32 + fr, fq * 8);
#define PG8_SA(b, h) (((b) * 2 + (h)) * HTB)
#define PG8_SB(b, h) ((4 + (b) * 2 + (h)) * HTB)
#define PG8_STAGE(bufoff, gbase, voff) do { _Pragma("unroll") for (int _i = 0; _i < 2; ++_i) \
        __builtin_amdgcn_global_load_lds((const unsigned*)((const char*)(gbase) + (voff)[_i]), (LAS unsigned*)(lds + (bufoff) + ldsw + _i * 8192), 16, 0, 0); } while (0)
#define PG8_LDA(dst, b, h) do { _Pragma("unroll") for (int m = 0; m < 4; ++m) _Pragma("unroll") for (int k = 0; k < 2; ++k) dst[m][k] = *(const LAS bf16x8*)(lds + PG8_SA(b, h) + aoff + m * 2048 + k * 1024); } while (0)
#define PG8_LDB(dst, b, h) do { _Pragma("unroll") for (int n = 0; n < 2; ++n) _Pragma("unroll") for (int k = 0; k < 2; ++k) dst[n][k] = *(const LAS bf16x8*)(lds + PG8_SB(b, h) + boff + n * 2048 + k * 1024); } while (0)
#define PG8_MMA(ai, bj, At, Bt) do { __builtin_amdgcn_s_setprio(1); _Pragma("unroll") for (int m = 0; m < 4; ++m) _Pragma("unroll") for (int n = 0; n < 2; ++n) _Pragma("unroll") for (int k = 0; k < 2; ++k) \
        acc[ai][bj][m][n] = __builtin_amdgcn_mfma_f32_16x16x32_bf16(Bt[n][k], At[m][k], acc[ai][bj][m][n], 0, 0, 0); __builtin_amdgcn_s_setprio(0); } while (0)
#define PG8_WAIT_V(n) asm volatile("s_waitcnt vmcnt(" #n ")" ::: "memory")
#define PG8_WAIT_L(n) asm volatile("s_waitcnt lgkmcnt(" #n ")" ::: "memory")
#define PG8_BAR __builtin_amdgcn_s_barrier()
#define PG8_SCHED __builtin_amdgcn_sched_barrier(0)
    Unit cur, nxt; int ui = 0;
    if (!S.next(0, cur)) return;
    f32x4 acc[2][2][4][2];
#pragma unroll
    for (int a = 0; a < 2; ++a)
#pragma unroll
        for (int b = 0; b < 2; ++b)
#pragma unroll
            for (int m = 0; m < 4; ++m)
#pragma unroll
                for (int n = 0; n < 2; ++n) acc[a][b][m][n] = (f32x4){0.f, 0.f, 0.f, 0.f};
    bf16x8 At[4][2], B0[2][2], B1[2][2];
    const char* cA = (const char*)g.A + (size_t)cur.pm * tstepA + (size_t)(cur.pn >> g.a_grp_shift) * g.a_grp_bytes;
    const char* cB = (const char*)g.Bt + (size_t)cur.pn * tstepB;
#ifndef PG8_SP2
#define PG8_SP2 1
#endif
#if PG8_SP2
    PG8_STAGE(PG8_SB(0, 0), cB, voffB); PG8_STAGE(PG8_SB(0, 1), cB + hstepB, voffB); PG8_STAGE(PG8_SA(0, 0), cA, voffA); PG8_STAGE(PG8_SA(0, 1), cA + hstepA, voffA);
    if (wr == 1) PG8_BAR;
    PG8_WAIT_V(2); PG8_BAR;
    PG8_STAGE(PG8_SB(1, 0), cB + kstep, voffB); PG8_STAGE(PG8_SA(1, 0), cA + kstep, voffA); PG8_STAGE(PG8_SB(1, 1), cB + hstepB + kstep, voffB);
    PG8_WAIT_V(6); PG8_BAR;
#else
    PG8_STAGE(PG8_SB(0, 0), cB, voffB); PG8_STAGE(PG8_SA(0, 0), cA, voffA); PG8_STAGE(PG8_SB(0, 1), cB + hstepB, voffB); PG8_STAGE(PG8_SA(0, 1), cA + hstepA, voffA);
    if (wr == 1) PG8_BAR;
    PG8_WAIT_V(4); PG8_BAR;
    PG8_STAGE(PG8_SB(1, 0), cB + kstep, voffB); PG8_STAGE(PG8_SA(1, 0), cA + kstep, voffA); PG8_STAGE(PG8_SB(1, 1), cB + hstepB + kstep, voffB);
    PG8_WAIT_V(6); PG8_BAR;
#endif
    for (;;) {
        const bool has_next = S.next(ui + 1, nxt);
        const char* nA = has_next ? (const char*)g.A + (size_t)nxt.pm * tstepA + (size_t)(nxt.pn >> g.a_grp_shift) * g.a_grp_bytes : cA;
        const char* nB = has_next ? (const char*)g.Bt + (size_t)nxt.pn * tstepB : cB;
        for (int t = 0; t < nt; t += 2) {
            const bool last = (t == nt - 2);
            const char* a1 = cA + (size_t)(t + 1) * kstep;
            const char* a2 = last ? nA : cA + (size_t)(t + 2) * kstep; const char* b2 = last ? nB : cB + (size_t)(t + 2) * kstep;
            const char* a3 = a2 + kstep; const char* b3 = b2 + kstep;
            if constexpr (Epi::SS_LDS) { if (last) {
                const char* sp = (const char*)E.ss + (size_t)cur.pm * (256 * 64) + (size_t)tid * 16;
                __builtin_amdgcn_global_load_lds((const unsigned*)sp, (LAS unsigned*)(lds + RS_OFF + ldsw), 16, 0, 0);
                __builtin_amdgcn_global_load_lds((const unsigned*)(sp + 8192), (LAS unsigned*)(lds + RS_OFF + 8192 + ldsw), 16, 0, 0); } }
#if PG8_SP2
            PG8_LDB(B0, 0, 0); PG8_LDB(B1, 0, 1); PG8_SCHED; PG8_LDA(At, 0, 0); PG8_STAGE(PG8_SA(1, 1), a1 + hstepA, voffA);
            PG8_WAIT_V(8); PG8_WAIT_L(0); PG8_BAR; PG8_MMA(0, 0, At, B0); PG8_MMA(0, 1, At, B1); PG8_BAR; PG8_SCHED;
            PG8_LDA(At, 0, 1); PG8_STAGE(PG8_SB(0, 0), b2, voffB); PG8_STAGE(PG8_SB(0, 1), b2 + hstepB, voffB); PG8_STAGE(PG8_SA(0, 0), a2, voffA);
            PG8_WAIT_V(8); PG8_WAIT_L(0); PG8_BAR; PG8_MMA(1, 0, At, B0); PG8_MMA(1, 1, At, B1); PG8_BAR; PG8_SCHED;
            PG8_LDB(B0, 1, 0); PG8_LDB(B1, 1, 1); PG8_SCHED; PG8_LDA(At, 1, 0); PG8_STAGE(PG8_SA(0, 1), a2 + hstepA, voffA);
            PG8_WAIT_V(8); PG8_WAIT_L(0); PG8_BAR; PG8_MMA(0, 0, At, B0); PG8_MMA(0, 1, At, B1); PG8_BAR; PG8_SCHED;
            PG8_LDA(At, 1, 1); PG8_STAGE(PG8_SB(1, 0), b3, voffB); PG8_STAGE(PG8_SB(1, 1), b3 + hstepB, voffB); PG8_STAGE(PG8_SA(1, 0), a3, voffA);
            PG8_WAIT_V(8); PG8_WAIT_L(0); PG8_BAR; PG8_MMA(1, 0, At, B0); PG8_MMA(1, 1, At, B1); PG8_BAR; PG8_SCHED;
#else
            PG8_LDB(B0, 0, 0); PG8_SCHED; PG8_LDA(At, 0, 0); PG8_STAGE(PG8_SA(1, 1), a1 + hstepA, voffA);
            PG8_WAIT_L(8); PG8_BAR; PG8_WAIT_L(0); PG8_MMA(0, 0, At, B0); PG8_BAR; PG8_SCHED;
            PG8_LDB(B1, 0, 1); PG8_STAGE(PG8_SB(0, 0), b2, voffB);
            PG8_BAR; PG8_WAIT_L(0); PG8_MMA(0, 1, At, B1); PG8_BAR;
            PG8_LDA(At, 0, 1); PG8_STAGE(PG8_SA(0, 0), a2, voffA);
            PG8_BAR; PG8_WAIT_L(0); PG8_MMA(1, 0, At, B0); PG8_BAR; PG8_SCHED;
            PG8_STAGE(PG8_SB(0, 1), b2 + hstepB, voffB);
            PG8_WAIT_V(6); PG8_BAR; PG8_MMA(1, 1, At, B1); PG8_BAR;
            PG8_LDB(B0, 1, 0); PG8_SCHED; PG8_LDA(At, 1, 0); PG8_STAGE(PG8_SA(0, 1), a2 + hstepA, voffA);
            PG8_WAIT_L(8); PG8_BAR; PG8_WAIT_L(0); PG8_MMA(0, 0, At, B0); PG8_BAR; PG8_SCHED;
            PG8_LDB(B1, 1, 1); PG8_STAGE(PG8_SB(1, 0), b3, voffB);
            PG8_BAR; PG8_WAIT_L(0); PG8_MMA(0, 1, At, B1); PG8_BAR;
            PG8_LDA(At, 1, 1); PG8_STAGE(PG8_SA(1, 0), a3, voffA);
            PG8_BAR; PG8_WAIT_L(0); PG8_MMA(1, 0, At, B0); PG8_BAR; PG8_SCHED;
            PG8_STAGE(PG8_SB(1, 1), b3 + hstepB, voffB);
            PG8_WAIT_V(6); PG8_BAR; PG8_MMA(1, 1, At, B1); PG8_BAR;
#endif
        }
        if (wr == 0) PG8_BAR;
        E(acc, cur, wr, wc, fr, fq);
        if (!has_next) break;
#pragma unroll
        for (int a = 0; a < 2; ++a)
#pragma unroll
            for (int b = 0; b < 2; ++b)
#pragma unroll
                for (int m = 0; m < 4; ++m)
#pragma unroll
                    for (int n = 0; n < 2; ++n) acc[a][b][m][n] = (f32x4){0.f, 0.f, 0.f, 0.f};
        cur = nxt; cA = nA; cB = nB; ++ui;
        if (wr == 1) PG8_BAR;
    }
    PG8_WAIT_V(0);
    PG8_BAR;
#undef PG8_SA
#undef PG8_SB
#undef PG8_STAGE
#undef PG8_LDA
#undef PG8_LDB
#undef PG8_MMA
#undef PG8_WAIT_V
#undef PG8_WAIT_L
#undef PG8_BAR
#undef PG8_SCHED
}
}
using pg8::Unit;
typedef f32x4 Acc[2][2][4][2];

__device__ __forceinline__ float row_rs_lds(int rt, int fq) {
    extern __shared__ __attribute__((aligned(16))) unsigned char lds_raw_[];
    const f32x4 v = *(const LAS f32x4*)((LAS unsigned char*)lds_raw_ + RS_OFF + rt * 64 + fq * 16);
    float s = (v[0] + v[1]) + (v[2] + v[3]);
    s = red4_sum(s);
    return __builtin_amdgcn_rsqf(s * (1.0f / D) + EPS);
}
#define ROW_RS(u, ai, m) row_rs_lds((ai) * 128 + wr * 64 + (m) * 16 + fr, fq)
__device__ __forceinline__ u32x4 pack8(const f32x4 a, const f32x4 b) {
    u32x4 w; w.x = cvt_pk_bf16(a[0], a[1]); w.y = cvt_pk_bf16(a[2], a[3]); w.z = cvt_pk_bf16(b[0], b[1]); w.w = cvt_pk_bf16(b[2], b[3]); return w;
}
#define ROWLOOP for (int ai = 0; ai < 2; ++ai) _Pragma("unroll") for (int m = 0; m < 4; ++m)
#define ROW_OF(u, ai, m) ((u).pm * 256 + (ai) * 128 + wr * 64 + (m) * 16 + fr)

struct EpiGU {
    static constexpr bool SS_LDS = true;
    const float* ss; bf16_t* act;
    __device__ __forceinline__ void operator()(const Acc& acc, const Unit& u, int wr, int wc, int fr, int fq) const {
        const int col0 = u.pn * 128 + wc * 32 + fq * 8;
#pragma unroll
        ROWLOOP {
            const int row = ROW_OF(u, ai, m); const float rs = ROW_RS(u, ai, m); const float c1 = -rs * LOG2E, rs2 = rs * rs;
            f32x4 o[2];
#pragma unroll
            for (int n = 0; n < 2; ++n) {
                const f32x4 gv = acc[ai][0][m][n], gu = gv * acc[ai][1][m][n], t = gv * c1; f32x4 r;
#pragma unroll
                for (int e = 0; e < 4; ++e) r[e] = __builtin_amdgcn_rcpf(1.0f + __builtin_amdgcn_exp2f(t[e]));
                o[n] = gu * (r * rs2);
            }
            *(u32x4*)(act + (size_t)row * FF + col0) = pack8(o[0], o[1]);
        }
    }
};
__device__ __forceinline__ f32x4 bf4_lo(const u32x4 w) { return (f32x4){bf_lo(w.x), bf_hi(w.x), bf_lo(w.y), bf_hi(w.y)}; }
__device__ __forceinline__ f32x4 bf4_hi(const u32x4 w) { return (f32x4){bf_lo(w.z), bf_hi(w.z), bf_lo(w.w), bf_hi(w.w)}; }
template <bool BASE_F32> struct EpiRes {
    static constexpr bool SS_LDS = false;
    const void* base; bf16_t* hb; float* ss_out; float scale;
    __device__ __forceinline__ void operator()(const Acc& acc, const Unit& u, int wr, int wc, int fr, int fq) const {
        const int colb = u.pn * 256 + wc * 32 + fq * 8;
#pragma unroll
        for (int ai = 0; ai < 2; ++ai) {
            f32x4 hv[4][2][2];
            if constexpr (BASE_F32) {
#pragma unroll
                for (int m = 0; m < 4; ++m)
#pragma unroll
                    for (int bj = 0; bj < 2; ++bj) { const size_t off = (size_t)ROW_OF(u, ai, m) * D + colb + bj * 128; hv[m][bj][0] = *(const f32x4*)((const float*)base + off); hv[m][bj][1] = *(const f32x4*)((const float*)base + off + 4); }
            } else {
                u32x4 hw[4][2];
#pragma unroll
                for (int m = 0; m < 4; ++m)
#pragma unroll
                    for (int bj = 0; bj < 2; ++bj) hw[m][bj] = *(const u32x4*)((const bf16_t*)base + (size_t)ROW_OF(u, ai, m) * D + colb + bj * 128);
#pragma unroll
                for (int m = 0; m < 4; ++m)
#pragma unroll
                    for (int bj = 0; bj < 2; ++bj) { hv[m][bj][0] = bf4_lo(hw[m][bj]); hv[m][bj][1] = bf4_hi(hw[m][bj]); }
            }
#pragma unroll
            for (int m = 0; m < 4; ++m) {
                const int row = ROW_OF(u, ai, m); float sq = 0.f;
#pragma unroll
                for (int bj = 0; bj < 2; ++bj) {
                    const size_t off = (size_t)row * D + colb + bj * 128;
                    const f32x4 h0 = hv[m][bj][0] + acc[ai][bj][m][0] * scale, h1 = hv[m][bj][1] + acc[ai][bj][m][1] * scale;
                    *(u32x4*)(hb + off) = pack8(h0, h1);
                    sq += (h0[0] * h0[0] + h0[1] * h0[1]) + (h0[2] * h0[2] + h0[3] * h0[3]) + (h1[0] * h1[0] + h1[1] * h1[1]) + (h1[2] * h1[2] + h1[3] * h1[3]);
                }
                sq = red4_sum(sq);
                if (fq == 0) ss_out[(size_t)row * 16 + u.pn * 4 + wc] = sq;
            }
            asm volatile("" ::: "memory");
        }
    }
};
template <bool OUT_F32> struct EpiPle {
    static constexpr bool SS_LDS = true;
    const float* ss; const bf16_t* pp; const bf16_t* hin; float* outf; bf16_t* hb; float* ss_out;
    __device__ __forceinline__ void operator()(const Acc& acc, const Unit& u, int wr, int wc, int fr, int fq) const {
        const int colb = u.pn * 256 + wc * 32 + fq * 8;
#pragma unroll
        for (int ai = 0; ai < 2; ++ai) {
            u32x4 hw[4][2], pv[4][2]; float rsv[4];
#pragma unroll
            for (int m = 0; m < 4; ++m) { const int row = ROW_OF(u, ai, m); rsv[m] = ROW_RS(u, ai, m);
#pragma unroll
                for (int bj = 0; bj < 2; ++bj) { const size_t off = (size_t)row * D + colb + bj * 128; hw[m][bj] = *(const u32x4*)(hin + off); pv[m][bj] = *(const u32x4*)(pp + off); } }
#pragma unroll
            for (int m = 0; m < 4; ++m) { const int row = ROW_OF(u, ai, m); const float rs = rsv[m]; float sq = 0.f;
#pragma unroll
                for (int bj = 0; bj < 2; ++bj) {
                    const size_t off = (size_t)row * D + colb + bj * 128;
                    f32x4 h0 = bf4_lo(hw[m][bj]), h1 = bf4_hi(hw[m][bj]); const f32x4 p0 = bf4_lo(pv[m][bj]), p1 = bf4_hi(pv[m][bj]);
#pragma unroll
                    for (int e = 0; e < 4; ++e) { h0[e] += fast_sigmoid(acc[ai][bj][m][0][e] * rs) * p0[e]; h1[e] += fast_sigmoid(acc[ai][bj][m][1][e] * rs) * p1[e]; }
                    if constexpr (OUT_F32) { *(f32x4*)(outf + off) = h0; *(f32x4*)(outf + off + 4) = h1; }
                    else { *(u32x4*)(hb + off) = pack8(h0, h1);
                        sq += (h0[0] * h0[0] + h0[1] * h0[1]) + (h0[2] * h0[2] + h0[3] * h0[3]) + (h1[0] * h1[0] + h1[1] * h1[1]) + (h1[2] * h1[2] + h1[3] * h1[3]); }
                }
                if constexpr (!OUT_F32) { sq = red4_sum(sq); if (fq == 0) ss_out[(size_t)row * 16 + u.pn * 4 + wc] = sq; }
            }
            asm volatile("" ::: "memory");
        }
    }
};
struct EpiPlain {
    static constexpr bool SS_LDS = false;
    bf16_t* o;
    __device__ __forceinline__ void operator()(const Acc& acc, const Unit& u, int wr, int wc, int fr, int fq) const {
#pragma unroll
        ROWLOOP {
            const int row = ROW_OF(u, ai, m);
#pragma unroll
            for (int bj = 0; bj < 2; ++bj) *(u32x4*)(o + (size_t)row * D + u.pn * 256 + bj * 128 + wc * 32 + fq * 8) = pack8(acc[ai][bj][m][0], acc[ai][bj][m][1]);
        }
    }
};
struct EpiHin {
    static constexpr bool SS_LDS = true;
    const float* ss; bf16_t *GB, *U, *Q, *Kb, *V; const float *qg, *kg;
    __device__ __forceinline__ void operator()(const Acc& acc, const Unit& u, int wr, int wc, int fr, int fq) const {
        const int pn = u.pn;
        if (pn < 2 || pn >= 10) {
            bf16_t* o = pn < 2 ? GB : V; const int ct = (pn < 2 ? pn : pn - 10) * 256;
#pragma unroll
            ROWLOOP { const int row = ROW_OF(u, ai, m); const float rs = ROW_RS(u, ai, m);
#pragma unroll
                for (int bj = 0; bj < 2; ++bj) *(u32x4*)(o + (size_t)row * CW + ct + bj * 128 + wc * 32 + fq * 8) = pack8(acc[ai][bj][m][0] * rs, acc[ai][bj][m][1] * rs); }
        } else if (pn < 6) {
            const int ct = (pn - 2) * 128;
#pragma unroll
            ROWLOOP { const int row = ROW_OF(u, ai, m); const float rs = ROW_RS(u, ai, m); const float r2 = rs * rs;
                *(u32x4*)(U + (size_t)row * CW + ct + wc * 32 + fq * 8) = pack8(acc[ai][0][m][0] * acc[ai][1][m][0] * r2, acc[ai][0][m][1] * acc[ai][1][m][1] * r2); }
        } else {
            const bool isq = pn < 8; bf16_t* o = isq ? Q : Kb; const float* gp = isq ? qg : kg; const float sc = isq ? QSCALE : 1.0f;
            const int head = 4 * (pn & 1) + wc;
            f32x4 gn[2][2];
#pragma unroll
            for (int bj = 0; bj < 2; ++bj)
#pragma unroll
                for (int n = 0; n < 2; ++n) gn[bj][n] = *(const f32x4*)(gp + bj * 32 + fq * 8 + n * 4) * sc;
#pragma unroll
            ROWLOOP { const int row = ROW_OF(u, ai, m); const float rs = ROW_RS(u, ai, m);
                f32x4 v[2][2]; float sq = 0.f;
#pragma unroll
                for (int bj = 0; bj < 2; ++bj)
#pragma unroll
                    for (int n = 0; n < 2; ++n) { v[bj][n] = acc[ai][bj][m][n] * rs; sq += (v[bj][n][0] * v[bj][n][0] + v[bj][n][1] * v[bj][n][1]) + (v[bj][n][2] * v[bj][n][2] + v[bj][n][3] * v[bj][n][3]); }
                sq = red4_sum(sq);
                const float rr = __builtin_amdgcn_rsqf(sq * (1.0f / HD) + EPS);
#pragma unroll
                for (int bj = 0; bj < 2; ++bj) *(u32x4*)(o + (size_t)row * CW + head * 64 + bj * 32 + fq * 8) = pack8(v[bj][0] * rr * gn[bj][0], v[bj][1] * rr * gn[bj][1]);
            }
        }
    }
};
struct EpiRin {
    static constexpr bool SS_LDS = true;
    const float* ss; bf16_t *XB, *GY;
    __device__ __forceinline__ void operator()(const Acc& acc, const Unit& u, int wr, int wc, int fr, int fq) const {
        const bool isx = u.pn < 4; bf16_t* o = isx ? XB : GY; const int ct = (u.pn & 3) * 256;
#pragma unroll
        ROWLOOP { const int row = ROW_OF(u, ai, m); const float rs = ROW_RS(u, ai, m);
#pragma unroll
            for (int bj = 0; bj < 2; ++bj) {
                f32x4 v0 = acc[ai][bj][m][0] * rs, v1 = acc[ai][bj][m][1] * rs;
                if (!isx) {
#pragma unroll
                    for (int e = 0; e < 4; ++e) { float x = v0[e]; v0[e] = x * fast_sigmoid(1.5957691216f * (x + 0.044715f * x * x * x)); x = v1[e]; v1[e] = x * fast_sigmoid(1.5957691216f * (x + 0.044715f * x * x * x)); }
                }
                *(u32x4*)(o + (size_t)row * D + ct + bj * 128 + wc * 32 + fq * 8) = pack8(v0, v1);
            } }
    }
};
__device__ __forceinline__ float neg_expm1(float x) {
    const float p = -x * (1.0f + x * (0.5f + x * (0.16666667f + x * (0.041666668f + x * (0.0083333338f + x * 0.0013888889f)))));
    const float q = 1.0f - __expf(x);
    return x > -0.3f ? p : q;
}
struct EpiGates {
    static constexpr bool SS_LDS = false;
    const bf16_t* xc; const float *ba, *bx, *sp8; bf16_t* Lout; bf16_t* Uout;
    __device__ __forceinline__ void operator()(const Acc& acc, const Unit& u, int wr, int wc, int fr, int fq) const {
        const int c0 = (u.pn >> 1) * 256 + (u.pn & 1) * 128 + wc * 32 + fq * 8;
        u32x4 xw[2][4];
#pragma unroll
        for (int ai = 0; ai < 2; ++ai)
#pragma unroll
            for (int m = 0; m < 4; ++m) xw[ai][m] = *(const u32x4*)(xc + (size_t)ROW_OF(u, ai, m) * D + c0);
        f32x4 vba[2], vbx[2], vsp[2];
#pragma unroll
        for (int n = 0; n < 2; ++n) { vba[n] = *(const f32x4*)(ba + c0 + 4 * n); vbx[n] = *(const f32x4*)(bx + c0 + 4 * n); vsp[n] = *(const f32x4*)(sp8 + c0 + 4 * n); }
#pragma unroll
        ROWLOOP { const int row = ROW_OF(u, ai, m); const size_t off = (size_t)row * D + c0;
            const u32x4 w = xw[ai][m];
            const f32x4 xv[2] = {{bf_lo(w.x), bf_hi(w.x), bf_lo(w.y), bf_hi(w.y)}, {bf_lo(w.z), bf_hi(w.z), bf_lo(w.w), bf_hi(w.w)}};
            f32x4 av[2], uv[2];
#pragma unroll
            for (int n = 0; n < 2; ++n)
#pragma unroll
                for (int e = 0; e < 4; ++e) {
                    const float ra = fast_sigmoid(acc[ai][0][m][n][e] + vba[n][e]);
                    const float la = -ra * vsp[n][e];
                    av[n][e] = la * LOG2E;
                    uv[n][e] = __builtin_sqrtf(neg_expm1(2.0f * la)) * fast_sigmoid(acc[ai][1][m][n][e] + vbx[n][e]) * xv[n][e];
                }
            *(u32x4*)(Lout + off) = pack8(av[0], av[1]);
            *(u32x4*)(Uout + off) = pack8(uv[0], uv[1]);
        }
    }
};

struct Job { const float* W; const float* gain; bf16_t* WT; int K, N, mode, row_base, start, pad; };
constexpr int NJOBS = 28;
struct Args { const float* in[29]; float* out; unsigned char* ws; Job jobs[NJOBS]; int ph_lo, ph_hi, nitems, pad; };

constexpr int LDS_BYTES = 131072 + 2048 + 16384;

__device__ __forceinline__ int map_pair(int n0, int up) { return (n0 >> 7) * 256 + up * 128 + (n0 & 127); }
__device__ __forceinline__ int map_head(int l) { const int head = l >> 6, x0 = l & 63; return (head >> 2) * 256 + 128 * (x0 >> 5) + 32 * (head & 3); }
__device__ __forceinline__ int map_row(int mode, int n0) {
    if (mode == 0) return n0;
    if (mode == 1) return map_pair(n0, 0);
    if (mode == 2) return map_pair(n0, 1);
    const int sec = n0 >> 9, l = n0 & 511;
    if (sec == 0) return l;
    if (sec == 1) return 512 + map_pair(l, 0);
    if (sec == 2) return 512 + map_pair(l, 1);
    if (sec == 3) return 1536 + map_head(l);
    if (sec == 4) return 2048 + map_head(l);
    return 2560 + l;
}
struct P0Item { const float* src; const float* gain; bf16_t* dst; int K, k0; };
__device__ __forceinline__ void p0_decode(const Args& args, int it, P0Item& o, int& N) {
    int j = 0;
#pragma unroll 1
    for (int q = 1; q < NJOBS; ++q) if (it >= args.jobs[q].start) j = q;
    const Job& jb = args.jobs[j]; const int item = it - jb.start;
    const int K = jb.K; N = jb.N; const int nblk = N / 32, kb = item / nblk, nb = item % nblk, k0 = 64 * kb, n0 = 32 * nb;
    o.src = jb.W + (size_t)k0 * N + n0; o.gain = jb.gain ? jb.gain + k0 : nullptr; o.K = K; o.k0 = k0;
    o.dst = jb.WT + (size_t)(jb.row_base + map_row(jb.mode, n0)) * K + k0;
}
__device__ __forceinline__ void p0_load(const P0Item& p, int N, int lane, f32x4 (&v)[8], float (&gk)[8]) {
    const int r8 = lane >> 3, c4 = lane & 7;
#pragma unroll
    for (int i = 0; i < 8; ++i) { const int kk = 8 * i + r8; v[i] = __builtin_nontemporal_load((const f32x4*)(p.src + (size_t)kk * N + 4 * c4)); gk[i] = p.gain ? p.gain[kk] : 1.0f; }
}
__device__ __forceinline__ void p0_emit(const P0Item& p, LAS float* scr, int lane, const f32x4 (&v)[8], const float (&gk)[8]) {
    const int r8 = lane >> 3, c4 = lane & 7;
#pragma unroll
    for (int i = 0; i < 8; ++i) { const int kk = 8 * i + r8; LAS float* d = scr + kk * 33 + 4 * c4; d[0] = v[i][0] * gk[i]; d[1] = v[i][1] * gk[i]; d[2] = v[i][2] * gk[i]; d[3] = v[i][3] * gk[i]; }
    asm volatile("s_waitcnt lgkmcnt(0)" ::: "memory");
    const int c = lane & 7;
#pragma unroll
    for (int j = 0; j < 4; ++j) { const int n = (lane >> 3) + 8 * j; const LAS float* sp = scr + (8 * c) * 33 + n;
        u32x4 o; o.x = cvt_pk_bf16(sp[0 * 33], sp[1 * 33]); o.y = cvt_pk_bf16(sp[2 * 33], sp[3 * 33]); o.z = cvt_pk_bf16(sp[4 * 33], sp[5 * 33]); o.w = cvt_pk_bf16(sp[6 * 33], sp[7 * 33]);
        *(u32x4*)(p.dst + (size_t)n * p.K + 8 * c) = o; }
    asm volatile("s_waitcnt lgkmcnt(0)" ::: "memory");
}

__device__ __forceinline__ int rel_bucket(int dist) {
    if (dist < 16) return dist;
    const float n = (float)dist;
    int large = 16 + (int)(logf(n / 16.0f) / 4.852030263919617f * 16.0f);
    return large < 31 ? large : 31;
}

typedef short v4i16_t __attribute__((ext_vector_type(4)));
constexpr int QS_STR = 144, V_STR = 160;
constexpr int LDS_Q = 0, LDS_K = LDS_Q + 128 * QS_STR, LDS_V = LDS_K + 256 * QS_STR, LDS_BT = LDS_V + 256 * V_STR, LDS_ATT_END = LDS_BT + 336 * 4;
static_assert(LDS_ATT_END <= 131072, "attention LDS");
constexpr int ATT_UNITS = 1536;
struct AItem { int g, h, dsh, n, r, first; size_t tokb; };
__device__ __forceinline__ void attn_decode(int unit, int j, AItem& a) {
    const int g = unit / 512, rem = unit % 512, b = rem / 128, rem2 = rem % 128, h = rem2 / 16, w4 = rem2 % 16;
    a.g = g; a.h = h; a.dsh = 2 * g; const int cpr = 16 >> a.dsh;
    a.r = w4 / cpr; a.n = (w4 % cpr) * 4 + j; a.first = (j == 0); a.tokb = (size_t)b * SEQ;
}
__device__ __forceinline__ void attn_fetch(const AItem& a, int tid, const bf16_t* Q, const bf16_t* Kb, const bf16_t* V, const float* biasT,
                                           u32x4 (&qv)[2], u32x4 (&kc)[2], u32x4 (&vc)[2], u32x4 (&kp)[2], u32x4 (&vp)[2], float& bt) {
    const int chunk = tid & 7;
#pragma unroll
    for (int j = 0; j < 2; ++j) { const int row = (tid >> 3) + 64 * j; const size_t tok = a.tokb + (size_t)((a.n * 128 + row) << a.dsh) + a.r; const size_t off = tok * CW + a.h * 64 + chunk * 8;
        qv[j] = *(const u32x4*)(Q + off); kc[j] = *(const u32x4*)(Kb + off); vc[j] = *(const u32x4*)(V + off); }
    if (a.first) {
#pragma unroll
        for (int j = 0; j < 2; ++j) { const int row = (tid >> 3) + 64 * j; int mk = (a.n - 1) * 128 + row; mk = mk < 0 ? 0 : mk; const size_t tok = a.tokb + (size_t)(mk << a.dsh) + a.r; const size_t off = tok * CW + a.h * 64 + chunk * 8;
            kp[j] = *(const u32x4*)(Kb + off); vp[j] = *(const u32x4*)(V + off); }
    }
    bt = biasT[(a.g * NH + a.h) * 129 + (tid < 128 ? tid : 128)];
}
__device__ __forceinline__ void attn_phase(LAS unsigned char* lds, int tid, int vcu, int G, const bf16_t* Q, const bf16_t* Kb, const bf16_t* V, bf16_t* OB, float* LSE, const float* biasT) {
    const int lane = tid & 63, w = __builtin_amdgcn_readfirstlane(tid >> 6), fr = lane & 15, fq = lane >> 4;
    u32x4 qv[2], kc[2], vc[2], kp[2], vp[2]; float bt; AItem cur, nxt;
#define ATT_BAR() asm volatile("s_waitcnt lgkmcnt(0)\n\ts_barrier" ::: "memory")
    f32x4 po[4]; float plse = 0.f; size_t ptok = 0; int pg = 0, ph = 0; bool have_prev = false;
#pragma unroll
    for (int dt = 0; dt < 4; ++dt) po[dt] = (f32x4){0.f, 0.f, 0.f, 0.f};
    const int qi = 16 * w + fr;
#define ATT_FLUSH() do { if (have_prev) { bf16_t* op_ = OB + (size_t)pg * T * CW + ptok * CW + ph * 64 + 4 * fq; \
        _Pragma("unroll") for (int dt = 0; dt < 4; ++dt) { u32x2 wv; wv.x = cvt_pk_bf16(po[dt][0], po[dt][1]); wv.y = cvt_pk_bf16(po[dt][2], po[dt][3]); *(u32x2*)(op_ + 16 * dt) = wv; } \
        if (fq == 0) LSE[(size_t)pg * T * NH + ptok * NH + ph] = plse; } } while (0)
    if (tid < 336) *(LAS float*)(lds + LDS_BT + tid * 4) = -INFINITY;
    __syncthreads();
    int unit = vcu, it = 0;
    if (unit < ATT_UNITS) { attn_decode(unit, 0, cur); attn_fetch(cur, tid, Q, Kb, V, biasT, qv, kc, vc, kp, vp, bt); }
    while (unit < ATT_UNITS) {
        const int par = it & 1;
        {
            const int chunk = tid & 7;
#pragma unroll
            for (int j = 0; j < 2; ++j) { const int row = (tid >> 3) + 64 * j;
                *(LAS u32x4*)(lds + LDS_Q + row * QS_STR + chunk * 16) = qv[j];
                *(LAS u32x4*)(lds + LDS_K + (par * 128 + row) * QS_STR + chunk * 16) = kc[j];
                *(LAS u32x4*)(lds + LDS_V + (par * 128 + row) * V_STR + chunk * 16) = vc[j]; }
            if (cur.first) {
#pragma unroll
                for (int j = 0; j < 2; ++j) { const int row = (tid >> 3) + 64 * j;
                    *(LAS u32x4*)(lds + LDS_K + ((par ^ 1) * 128 + row) * QS_STR + chunk * 16) = kp[j];
                    *(LAS u32x4*)(lds + LDS_V + ((par ^ 1) * 128 + row) * V_STR + chunk * 16) = vp[j]; }
            }
            if (tid < 129) *(LAS float*)(lds + LDS_BT + (160 + tid) * 4) = bt;
        }
        ATT_BAR();
        const int g = cur.g, h = cur.h, dsh = cur.dsh, n = cur.n, r = cur.r; const size_t tokb = cur.tokb;
        int nunit = unit, nj = (it & 3) + 1; if (nj == 4) { nj = 0; nunit += G; }
        if (nunit < ATT_UNITS) { attn_decode(nunit, nj, nxt); attn_fetch(nxt, tid, Q, Kb, V, biasT, qv, kc, vc, kp, vp, bt); cur = nxt; }
        ATT_FLUSH();
        const int kt0 = w < 6 ? w : 6, tx = par ? 0 : 8;
        bf16x8 qop[2], kop[10][2];
#pragma unroll
        for (int ks = 0; ks < 2; ++ks) qop[ks] = *(const LAS bf16x8*)(lds + LDS_Q + qi * QS_STR + (32 * ks + 8 * fq) * 2);
#pragma unroll
        for (int t = 0; t < 10; ++t)
#pragma unroll
            for (int ks = 0; ks < 2; ++ks) kop[t][ks] = *(const LAS bf16x8*)(lds + LDS_K + (16 * ((kt0 + t) ^ tx) + fr) * QS_STR + (32 * ks + 8 * fq) * 2);
        f32x4 s[10];
#pragma unroll
        for (int t = 0; t < 10; ++t) { s[t] = (f32x4){0.f, 0.f, 0.f, 0.f};
#pragma unroll
            for (int ks = 0; ks < 2; ++ks) s[t] = __builtin_amdgcn_mfma_f32_16x16x32_bf16(kop[t][ks], qop[ks], s[t], 0, 0, 0); }
        const LAS unsigned char* btb = lds + LDS_BT + 4 * (13 + qi + 128 - 16 * kt0 - 4 * fq);
        float mx = -INFINITY;
#pragma unroll
        for (int t = 0; t < 10; ++t)
#pragma unroll
            for (int e = 0; e < 4; ++e) s[t][e] += *(const LAS float*)(btb + 4 * (147 - 16 * t - e));
        if (n == 0) {
#pragma unroll
            for (int t = 0; t < 10; ++t)
#pragma unroll
                for (int e = 0; e < 4; ++e) if (16 * (kt0 + t) + 4 * fq + e < 128) s[t][e] = -INFINITY;
        }
#pragma unroll
        for (int t = 0; t < 10; ++t)
#pragma unroll
            for (int e = 0; e < 4; ++e) mx = fmaxf(mx, s[t][e]);
        mx = red4_max(mx);
        float l = 0.f;
#pragma unroll
        for (int t = 0; t < 10; ++t)
#pragma unroll
            for (int e = 0; e < 4; ++e) { const float p = __builtin_amdgcn_exp2f(s[t][e] - mx); s[t][e] = p; l += p; }
        l = red4_sum(l);
        f32x4 o[4];
#pragma unroll
        for (int dt = 0; dt < 4; ++dt) o[dt] = (f32x4){0.f, 0.f, 0.f, 0.f};
        const int tq = (lane & 15) >> 2, tp = lane & 3;
#pragma unroll
        for (int c = 0; c < 5; ++c) {
            const u32x4 pw = pack8(s[2 * c], s[2 * c + 1]); const bf16x8 pop = __builtin_bit_cast(bf16x8, pw);
            const int pt0 = (kt0 + 2 * c) ^ tx, pt1 = (kt0 + 2 * c + 1) ^ tx;
#pragma unroll
            for (int dt = 0; dt < 4; ++dt) {
                const v4i16_t lo = __builtin_amdgcn_ds_read_tr16_b64_v4i16((LAS v4i16_t*)(lds + LDS_V + (16 * pt0 + 4 * fq + tq) * V_STR + (16 * dt + 4 * tp) * 2));
                const v4i16_t hi = __builtin_amdgcn_ds_read_tr16_b64_v4i16((LAS v4i16_t*)(lds + LDS_V + (16 * pt1 + 4 * fq + tq) * V_STR + (16 * dt + 4 * tp) * 2));
                const bf16x8 vop = {lo[0], lo[1], lo[2], lo[3], hi[0], hi[1], hi[2], hi[3]};
                o[dt] = __builtin_amdgcn_mfma_f32_16x16x32_bf16(vop, pop, o[dt], 0, 0, 0);
            }
        }
        const float rl = __builtin_amdgcn_rcpf(l);
#pragma unroll
        for (int dt = 0; dt < 4; ++dt) po[dt] = o[dt] * rl;
        plse = mx + __builtin_amdgcn_logf(l);
        ptok = tokb + (size_t)((n * 128 + qi) << dsh) + r; pg = g; ph = h; have_prev = true;
        ATT_BAR();
        unit = nunit; ++it;
    }
    ATT_FLUSH();
#undef ATT_BAR
#undef ATT_FLUSH
}

constexpr size_t WS_SP8 = WS_BIAS + 65536;
#define PBF(off) ((bf16_t*)(wsp + (off)))
#define PF32(off) ((float*)(wsp + (off)))
typedef __attribute__((address_space(1))) unsigned char gchar_t;
#define PHASE_BEGIN gchar_t* wsp = (gchar_t*)args.ws; asm volatile("" : "+s"(wsp)); gchar_t* outp = (gchar_t*)args.out; asm volatile("" : "+s"(outp)); (void)outp; int bxp = blockIdx.x; asm volatile("" : "+s"(bxp)); \
    int tid; asm volatile("v_mbcnt_lo_u32_b32 %0, -1, 0\n\tv_mbcnt_hi_u32_b32 %0, -1, %0" : "=v"(tid)); tid += wave_s * 64; \
    const int vcu = (G % 8 == 0) ? (bxp % 8) * (G / 8) + bxp / 8 : bxp; (void)vcu; (void)wsp; (void)tid
#define GEMM(EPI, e, Aptr, Bptr, M_, N_, K_, lda_, ldb_, gsh, gby) do { int Ko_ = K_; asm volatile("" : "+s"(Ko_)); pg8::Gemm g_{(const bf16_t*)(Aptr), (const bf16_t*)(Bptr), M_, N_, Ko_, lda_, ldb_, gsh, gby}; \
        pg8::StaticOrder S_; S_.init(M_, N_, G, bxp); pg8::gemm_phase<EPI>(lds, tid, g_, S_, e); } while (0)

#define XB_TMO      128
#define XB_XCNT(j)  (256  + 64 * (j))
#define XB_XSUB(j)  (1280 + 64 * (j))
#define XB_XGEN(j)  (2304 + 64 * (j))
#define XB_TOP      3328
#define XB_TOPGEN   3392
#define XCD_BAR_WORDS 3456
#define XB_SPIN_CAP (1u << 22)
__device__ __forceinline__ unsigned xb_ld(unsigned* p)              { return __hip_atomic_load(p, __ATOMIC_RELAXED, __HIP_MEMORY_SCOPE_AGENT); }
__device__ __forceinline__ unsigned xb_add(unsigned* p, unsigned v) { return __hip_atomic_fetch_add(p, v, __ATOMIC_RELAXED, __HIP_MEMORY_SCOPE_AGENT); }
__device__ __forceinline__ unsigned xb_xcc_id() { return (unsigned)__builtin_amdgcn_s_getreg((3 << 11) | 20) & 0xFu; }
#define XB_SPIN(cond, bar) do { unsigned _sp = 0; while (cond) { __builtin_amdgcn_s_sleep(1); \
    if ((++_sp & 255u) == 0u) { if (xb_ld(&(bar)[XB_TMO])) break; if (_sp > XB_SPIN_CAP) { atomicAdd(&(bar)[XB_TMO], 1u); break; } } } } while (0)
__device__ __forceinline__ bool is_leader(int wave_s) { int lane; asm volatile("v_mbcnt_lo_u32_b32 %0, -1, 0\n\tv_mbcnt_hi_u32_b32 %0, -1, %0" : "=v"(lane)); return wave_s == 0 && lane == 0; }
__device__ __forceinline__ void xcd_barrier_complete(unsigned* bar, unsigned x, unsigned G, unsigned& nloc, unsigned& nx) {
    unsigned sum, cnt, mine, sp = 0u;
    for (;;) {
        sum = 0u; cnt = 0u; mine = 0u;
#pragma unroll
        for (unsigned j = 0; j < 16; ++j) { const unsigned c = xb_ld(&bar[XB_XCNT(j)]); sum += c; cnt += (c > 0u) ? 1u : 0u; mine = (j == x) ? c : mine; }
        if (sum == G) break;
        __builtin_amdgcn_s_sleep(1);
        if ((++sp & 255u) == 0u) { if (xb_ld(&bar[XB_TMO])) break; if (sp > XB_SPIN_CAP) { atomicAdd(&bar[XB_TMO], 1u); break; } }
    }
    nloc = mine > 0u ? mine : 1u; nx = cnt > 0u ? cnt : 1u;
}
__device__ __forceinline__ void grid_bar(unsigned* bar, volatile LAS unsigned* st, int wave_s, unsigned G) {
    asm volatile("s_waitcnt vmcnt(0) lgkmcnt(0)" ::: "memory");
    __syncthreads();
    if (is_leader(wave_s)) {
        const unsigned x = xb_xcc_id();
        unsigned nloc = st[0], nx = st[1];
        if (nloc == 0u) { xcd_barrier_complete(bar, x, G, nloc, nx); st[0] = nloc; st[1] = nx; }
        const unsigned old = xb_add(&bar[XB_XSUB(x)], 1u);
        const unsigned gen = old / nloc;
        if (old + 1u == (gen + 1u) * nloc) {
            __builtin_amdgcn_fence(__ATOMIC_RELEASE, "agent");
            asm volatile("s_waitcnt vmcnt(0)" ::: "memory");
            const unsigned og = xb_add(&bar[XB_TOP], 1u);
            const unsigned tg = og / nx;
            if (og + 1u == (tg + 1u) * nx) xb_add(&bar[XB_TOPGEN], 1u);
            else XB_SPIN(xb_ld(&bar[XB_TOPGEN]) == tg, bar);
            __builtin_amdgcn_fence(__ATOMIC_ACQUIRE, "agent");
            xb_add(&bar[XB_XGEN(x)], 1u);
            asm volatile("s_waitcnt vmcnt(0)" ::: "memory");
        } else {
            XB_SPIN(xb_ld(&bar[XB_XGEN(x)]) == gen, bar);
            __builtin_amdgcn_fence(__ATOMIC_ACQUIRE, "agent");
            asm volatile("s_waitcnt vmcnt(0)" ::: "memory");
        }
    }
    __syncthreads();
}
__device__ __forceinline__ bool phase_in(int lo, int hi, int k) { asm volatile("" : "+s"(lo), "+s"(hi)); return lo <= k && k < hi; }
#ifndef PHMASK
#define PHMASK 0xffffffffu
#endif
#define IN(k) (((PHMASK >> (k)) & 1u) && phase_in(lo, hi, (k)))
#ifndef DUPMASK
#define DUPMASK 0u
#endif
#if DUPMASK
#ifndef DUPN
#define DUPN 1
#endif
__device__ __forceinline__ int phase_rep(int k) { int r = ((DUPMASK >> k) & 1u) ? 1 + DUPN : 1; asm volatile("" : "+s"(r)); return r; }
#define REP(k) for (int rep_ = 0, nrep_ = phase_rep(k); rep_ < nrep_; ++rep_)
#else
#define REP(k)
#endif
#ifndef DUPBAR
#define DUPBAR 1
#endif
#define SEAM(k) do { if (IN(k) && IN((k) + 1)) { for (int b_ = 0; b_ < DUPBAR; ++b_) grid_bar((unsigned*)args.ws, (volatile LAS unsigned*)(lds + 131072), wave_s, (unsigned)G); } } while (0)
template <int L> __device__ __forceinline__ void layer_body(const Args& args, LAS unsigned char* lds, const int G, const int lo, const int hi, const int wave_s, unsigned& nbar) {

        const size_t hbc_off = L == 0 ? WS_HB0 : WS_HB1;
        const int P_GU1 = L == 0 ? 1 : 10, P_DN1 = P_GU1 + 1;
        if (IN(P_GU1)) REP(P_GU1) { PHASE_BEGIN; EpiGU e{PF32(WS_SS0), PBF(WS_ACT)}; GEMM(EpiGU, e, wsp + hbc_off, wsp + W_GU + (size_t)(L * 2 + 0) * 11 * MiB, T, 2 * FF, D, D, D, 31, 0); }
        SEAM(P_GU1);
        if (IN(P_DN1)) REP(P_DN1) { PHASE_BEGIN; typedef EpiRes<L == 0> EpiR; EpiR e{L == 0 ? (const void*)args.in[0] : (const void*)PBF(hbc_off), PBF(hbc_off), PF32(WS_SS1), 0.5f}; GEMM(EpiR, e, wsp + WS_ACT, wsp + W_DN + (size_t)(L * 2 + 0) * 11 * MiB / 2, T, D, FF, FF, FF, 31, 0); }
        SEAM(P_DN1);
        if constexpr (L == 0) {
            constexpr size_t O_GB = WS_ACT, O_U = WS_ACT + (size_t)T * CW * 2, O_Q = WS_ACT + (size_t)2 * T * CW * 2, O_K = WS_ACT + (size_t)3 * T * CW * 2, O_V = WS_ACT + (size_t)4 * T * CW * 2;
            constexpr size_t O_YC = O_Q;
            if (IN(3)) REP(3) { PHASE_BEGIN; EpiHin e{PF32(WS_SS1), PBF(O_GB), PBF(O_U), PBF(O_Q), PBF(O_K), PBF(O_V), args.in[10], args.in[11]}; GEMM(EpiHin, e, wsp + WS_HB0, wsp + W_HIN, T, 3072, D, D, D, 31, 0); }
            SEAM(3);
            if (IN(4)) REP(4) { PHASE_BEGIN; attn_phase(lds, tid, vcu, G, PBF(O_Q), PBF(O_K), PBF(O_V), (bf16_t*)outp, PF32(WS_LSE), PF32(WS_BIAS)); }
            SEAM(4);
            if (IN(5)) REP(5) {
                PHASE_BEGIN;
                const float* cw = args.in[9]; const bf16_t *GB = PBF(O_GB), *U = PBF(O_U), *OB = (const bf16_t*)outp; bf16_t* YC = PBF(O_YC); const float* LSE = PF32(WS_LSE);
                const int c8 = (tid & 127) * 8; const int tstride = G * 4;
                if (c8 < CW) {
                    f32x4 wt[3][2];
#pragma unroll
                    for (int j = 0; j < 3; ++j) { wt[j][0] = *(const f32x4*)(cw + j * CW + c8); wt[j][1] = *(const f32x4*)(cw + j * CW + c8 + 4); }
                    for (int tb = vcu * 4 + (tid >> 7); tb < T; tb += 4 * tstride) {
                        u32x4 uw[4][3], gw_[4];
#pragma unroll
                        for (int q = 0; q < 4; ++q) { const int t = tb + q * tstride, sp = t & (SEQ - 1); if (t < T) {
#pragma unroll
                            for (int j = 0; j < 3; ++j) { const int back = 2 - j; uw[q][j] = (sp - back >= 0) ? *(const u32x4*)(U + (size_t)(t - back) * CW + c8) : (u32x4){0u, 0u, 0u, 0u}; }
                            gw_[q] = *(const u32x4*)(GB + (size_t)t * CW + c8); } }
#pragma unroll
                        for (int q = 0; q < 4; ++q) { const int t = tb + q * tstride; if (t < T) {
                            f32x4 y0 = {0.f, 0.f, 0.f, 0.f}, y1 = y0;
#pragma unroll
                            for (int j = 0; j < 3; ++j) { y0 += wt[j][0] * bf4_lo(uw[q][j]); y1 += wt[j][1] * bf4_hi(uw[q][j]); }
                            y0 *= bf4_lo(gw_[q]); y1 *= bf4_hi(gw_[q]);
                            *(u32x4*)(YC + (size_t)t * D + c8) = pack8(y0, y1); } }
                    }
                } else {
                    const int ch = c8 - CW, hd = ch >> 6;
                    for (int tb = vcu * 4 + (tid >> 7); tb < T; tb += 4 * tstride) {
                        u32x4 ow[4][3]; float lv[4][3];
#pragma unroll
                        for (int q = 0; q < 4; ++q) { const int t = tb + q * tstride; if (t < T) {
#pragma unroll
                            for (int g = 0; g < 3; ++g) { lv[q][g] = LSE[(size_t)g * T * NH + (size_t)t * NH + hd]; ow[q][g] = *(const u32x4*)(OB + (size_t)g * T * CW + (size_t)t * CW + ch); } } }
#pragma unroll
                        for (int q = 0; q < 4; ++q) { const int t = tb + q * tstride; if (t < T) {
                            const float mxl = fmaxf(lv[q][0], fmaxf(lv[q][1], lv[q][2]));
                            float w0 = __builtin_amdgcn_exp2f(lv[q][0] - mxl), w1 = __builtin_amdgcn_exp2f(lv[q][1] - mxl), w2 = __builtin_amdgcn_exp2f(lv[q][2] - mxl);
                            const float inv = __builtin_amdgcn_rcpf(w0 + w1 + w2); w0 *= inv; w1 *= inv; w2 *= inv;
                            const f32x4 y0 = bf4_lo(ow[q][0]) * w0 + bf4_lo(ow[q][1]) * w1 + bf4_lo(ow[q][2]) * w2, y1 = bf4_hi(ow[q][0]) * w0 + bf4_hi(ow[q][1]) * w1 + bf4_hi(ow[q][2]) * w2;
                            *(u32x4*)(YC + (size_t)t * D + c8) = pack8(y0, y1); } }
                    }
                }
            }
            SEAM(5);
            if (IN(6)) REP(6) { PHASE_BEGIN; typedef EpiRes<false> EpiR; EpiR e{PBF(WS_HB0), PBF(WS_HB0), PF32(WS_SS0), 1.0f}; GEMM(EpiR, e, wsp + O_YC, wsp + W_HOUT, T, D, D, D, D, 31, 0); }
            SEAM(6);
        } else {
            constexpr size_t O_XB = WS_HB0, O_GY = WS_PP, O_AA = WS_ACT;
#define XC_P ((bf16_t*)outp)
#define UU_P ((bf16_t*)(outp + 64 * MiB))
#define YR_P ((bf16_t*)outp)
            if (IN(12)) REP(12) { PHASE_BEGIN; EpiRin e{PF32(WS_SS1), PBF(O_XB), PBF(O_GY)}; GEMM(EpiRin, e, wsp + WS_HB1, wsp + W_RIN, T, 2048, D, D, D, 31, 0); }
            SEAM(12);
            if (IN(13)) REP(13) {
                PHASE_BEGIN;
                const float* cw = args.in[14]; const float* cb = args.in[15]; const bf16_t* XB = PBF(O_XB); bf16_t* XC = XC_P;
                const int c8 = (tid & 127) * 8; const int tstride = G * 4;
                f32x4 wt[4][2], bs[2];
#pragma unroll
                for (int j = 0; j < 4; ++j) { wt[j][0] = *(const f32x4*)(cw + j * D + c8); wt[j][1] = *(const f32x4*)(cw + j * D + c8 + 4); }
                bs[0] = *(const f32x4*)(cb + c8); bs[1] = *(const f32x4*)(cb + c8 + 4);
                for (int tb = vcu * 4 + (tid >> 7); tb < T; tb += 4 * tstride) {
                    u32x4 xw[4][4];
#pragma unroll
                    for (int q = 0; q < 4; ++q) { const int t = tb + q * tstride, sp = t & (SEQ - 1); if (t < T) {
#pragma unroll
                        for (int j = 0; j < 4; ++j) { const int back = 3 - j; xw[q][j] = (sp - back >= 0) ? *(const u32x4*)(XB + (size_t)(t - back) * D + c8) : (u32x4){0u, 0u, 0u, 0u}; } } }
#pragma unroll
                    for (int q = 0; q < 4; ++q) { const int t = tb + q * tstride; if (t < T) {
                        f32x4 y0 = bs[0], y1 = bs[1];
#pragma unroll
                        for (int j = 0; j < 4; ++j) { y0 += wt[j][0] * bf4_lo(xw[q][j]); y1 += wt[j][1] * bf4_hi(xw[q][j]); }
                        *(u32x4*)(XC + (size_t)t * D + c8) = pack8(y0, y1); } }
                }
            }
            SEAM(13);
            if (IN(14)) REP(14) { PHASE_BEGIN; EpiGates e{XC_P, args.in[17], args.in[19], PF32(WS_SP8), PBF(O_AA), UU_P}; GEMM(EpiGates, e, XC_P, wsp + W_LRU, T, 2048, 256, D, 256, 1, 512); }
            SEAM(14);
            if (IN(15)) REP(15) {
                PHASE_BEGIN; const bf16_t* LA = PBF(O_AA); const bf16_t* UU = UU_P; float* AGG = PF32(WS_AGG);
                for (int item = vcu; item < NBATCH * 64; item += G) {
                    const size_t t0 = (size_t)item * 128; f32x2 Ls = {0.f, 0.f}, Up = {0.f, 0.f};
                    unsigned lw[2][16], uw[2][16];
#pragma unroll
                    for (int t = 0; t < 16; ++t) { lw[0][t] = *(const unsigned*)(LA + (t0 + t) * D + 2 * tid); uw[0][t] = *(const unsigned*)(UU + (t0 + t) * D + 2 * tid); }
#pragma unroll
                    for (int tbi = 0; tbi < 8; ++tbi) { const int cb = tbi & 1, nb = cb ^ 1;
                        if (tbi < 7) {
#pragma unroll
                            for (int t = 0; t < 16; ++t) { lw[nb][t] = *(const unsigned*)(LA + (t0 + (tbi + 1) * 16 + t) * D + 2 * tid); uw[nb][t] = *(const unsigned*)(UU + (t0 + (tbi + 1) * 16 + t) * D + 2 * tid); } }
#pragma unroll
                        for (int t = 0; t < 16; ++t) { const f32x2 l2 = {bf_lo(lw[cb][t]), bf_hi(lw[cb][t])}; const f32x2 a = {__builtin_amdgcn_exp2f(l2[0]), __builtin_amdgcn_exp2f(l2[1])};
                            Ls += l2; Up = a * Up + (f32x2){bf_lo(uw[cb][t]), bf_hi(uw[cb][t])}; }
                        asm volatile("" ::: "memory"); }
                    *(f32x4*)(AGG + ((size_t)item * D + 2 * tid) * 2) = (f32x4){__builtin_amdgcn_exp2f(Ls[0]), __builtin_amdgcn_exp2f(Ls[1]), Up[0], Up[1]};
                }
            }
            SEAM(15);
            if (IN(16)) REP(16) {
                PHASE_BEGIN; const bf16_t* LA = PBF(O_AA); const bf16_t* UU = UU_P; const float* AGG = PF32(WS_AGG); const bf16_t* GY = PBF(O_GY); bf16_t* YR = YR_P;
                for (int item = vcu; item < NBATCH * 64; item += G) {
                    const int b = item >> 6, k = item & 63; const size_t t0 = (size_t)item * 128; f32x2 hs = {0.f, 0.f};
                    unsigned lw[2][16], uw[2][16], gw_[2][16];
#pragma unroll
                    for (int t = 0; t < 16; ++t) { lw[0][t] = *(const unsigned*)(LA + (t0 + t) * D + 2 * tid); uw[0][t] = *(const unsigned*)(UU + (t0 + t) * D + 2 * tid); gw_[0][t] = *(const unsigned*)(GY + (t0 + t) * D + 2 * tid); }
#pragma unroll 1
                    for (int jb = 0; jb < 64; jb += 8) { if (jb >= k) break; f32x4 au[8];
#pragma unroll
                        for (int j = 0; j < 8; ++j) au[j] = *(const f32x4*)(AGG + ((size_t)(b * 64 + jb + j) * D + 2 * tid) * 2);
#pragma unroll
                        for (int j = 0; j < 8; ++j) if (jb + j < k) hs = (f32x2){au[j][0], au[j][1]} * hs + (f32x2){au[j][2], au[j][3]}; }
#pragma unroll
                    for (int tbi = 0; tbi < 8; ++tbi) { const int cb = tbi & 1, nb = cb ^ 1;
                        if (tbi < 7) {
#pragma unroll
                            for (int t = 0; t < 16; ++t) { const size_t o_ = (t0 + (tbi + 1) * 16 + t) * D + 2 * tid; lw[nb][t] = *(const unsigned*)(LA + o_); uw[nb][t] = *(const unsigned*)(UU + o_); gw_[nb][t] = *(const unsigned*)(GY + o_); } }
#pragma unroll
                        for (int t = 0; t < 16; ++t) { const f32x2 a = {__builtin_amdgcn_exp2f(bf_lo(lw[cb][t])), __builtin_amdgcn_exp2f(bf_hi(lw[cb][t]))}; hs = a * hs + (f32x2){bf_lo(uw[cb][t]), bf_hi(uw[cb][t])};
                            *(unsigned*)(YR + (t0 + tbi * 16 + t) * D + 2 * tid) = cvt_pk_bf16(hs[0] * bf_lo(gw_[cb][t]), hs[1] * bf_hi(gw_[cb][t])); }
                        asm volatile("" ::: "memory"); }
                }
            }
            SEAM(16);
            if (IN(17)) REP(17) { PHASE_BEGIN; typedef EpiRes<false> EpiR; EpiR e{PBF(WS_HB1), PBF(WS_HB0), PF32(WS_SS0), 1.0f}; GEMM(EpiR, e, YR_P, wsp + W_ROUT, T, D, D, D, D, 31, 0); }
            SEAM(17);
        }
        const int P_GU2 = L == 0 ? 7 : 18, P_DN2 = P_GU2 + 1, P_PP = P_GU2 + 2, P_PLE = P_GU2 + 3;
        if (IN(P_GU2)) REP(P_GU2) { PHASE_BEGIN; EpiGU e{PF32(WS_SS0), PBF(WS_ACT)}; GEMM(EpiGU, e, wsp + WS_HB0, wsp + W_GU + (size_t)(L * 2 + 1) * 11 * MiB, T, 2 * FF, D, D, D, 31, 0); }
        SEAM(P_GU2);
        if (IN(P_DN2)) REP(P_DN2) { PHASE_BEGIN; typedef EpiRes<false> EpiR; EpiR e{PBF(WS_HB0), PBF(WS_HB0), PF32(WS_SS1), 0.5f}; GEMM(EpiR, e, wsp + WS_ACT, wsp + W_DN + (size_t)(L * 2 + 1) * 11 * MiB / 2, T, D, FF, FF, FF, 31, 0); }
        if (IN(P_DN2)) REP(21) { PHASE_BEGIN; EpiPlain e{PBF(WS_PP)}; GEMM(EpiPlain, e, wsp + WS_PB + (size_t)L * T * PLE * 2, wsp + W_PPW + (size_t)L * MiB / 2, T, D, PLE, PLE, PLE, 31, 0); }
        SEAM(P_DN2);
        (void)P_PP;
        if (IN(P_DN2 + 1)) REP(P_DN2 + 1) { PHASE_BEGIN; typedef EpiPle<L == 1> EpiP; EpiP e{PF32(WS_SS1), PBF(WS_PP), PBF(WS_HB0), args.out, PBF(WS_HB1), PF32(WS_SS0)}; GEMM(EpiP, e, wsp + WS_HB0, wsp + W_PG + (size_t)L * 2 * MiB, T, D, D, D, D, 31, 0); }
        (void)P_PLE;
        if (L == 0) SEAM(9);

}
__global__ void __launch_bounds__(512, 2) mk_fwd(Args args) {
    extern __shared__ __attribute__((aligned(16))) unsigned char lds_raw[];
    LAS unsigned char* lds = (LAS unsigned char*)lds_raw;
    const int G = gridDim.x;
    const int wave_s = __builtin_amdgcn_readfirstlane(threadIdx.x >> 6);
    const int lo = args.ph_lo, hi = args.ph_hi;
    if (threadIdx.x < 16) ((LAS unsigned*)(lds + 131072))[threadIdx.x] = 0u;
    if (hi - lo > 1) {
        if (threadIdx.x == 0) (void)xb_add(&((unsigned*)args.ws)[XB_XCNT(xb_xcc_id())], 1u);
        cg::this_grid().sync();
    }
    __syncthreads();

    unsigned nbar = 0;
    if (IN(0)) REP(0) {
        PHASE_BEGIN;
        const int lane = tid & 63, wave = __builtin_amdgcn_readfirstlane(tid >> 6);
        LAS float* scr = (LAS float*)(lds + wave * 16384);
        const int gw = vcu * 8 + wave, NGW = G * 8;
        {
            P0Item pc, pn; int Nc = 0, Nn = 0; f32x4 v[8], vn[8]; float gk[8], gkn[8];
            int it = gw;
            if (it < args.nitems) { p0_decode(args, it, pc, Nc); p0_load(pc, Nc, lane, v, gk); }
            for (; it < args.nitems; it += NGW) {
                const bool more = it + NGW < args.nitems;
                if (more) { p0_decode(args, it + NGW, pn, Nn); p0_load(pn, Nn, lane, vn, gkn); }
                p0_emit(pc, scr, lane, v, gk);
                if (more) { pc = pn; Nc = Nn;
#pragma unroll
                    for (int i = 0; i < 8; ++i) { v[i] = vn[i]; gk[i] = gkn[i]; } }
            }
        }
        const float* x = args.in[0]; bf16_t* HB0 = PBF(WS_HB0); float* SS0 = PF32(WS_SS0);
        for (int m0 = gw * 8; m0 < T; m0 += NGW * 8) {
            f32x4 v[8][4]; float sq[8];
#pragma unroll
            for (int r = 0; r < 8; ++r) { const f32x4* xr = (const f32x4*)(x + (size_t)(m0 + r) * D) + lane;
#pragma unroll
                for (int j = 0; j < 4; ++j) v[r][j] = __builtin_nontemporal_load(xr + 64 * j); }
#pragma unroll
            for (int r = 0; r < 8; ++r) { float s_ = 0.f;
#pragma unroll
                for (int j = 0; j < 4; ++j) s_ += (v[r][j][0] * v[r][j][0] + v[r][j][1] * v[r][j][1]) + (v[r][j][2] * v[r][j][2] + v[r][j][3] * v[r][j][3]);
                sq[r] = wave_sum(s_);
                u32x2* o8 = (u32x2*)(HB0 + (size_t)(m0 + r) * D) + lane;
#pragma unroll
                for (int j = 0; j < 4; ++j) { u32x2 wv; wv.x = cvt_pk_bf16(v[r][j][0], v[r][j][1]); wv.y = cvt_pk_bf16(v[r][j][2], v[r][j][3]); o8[64 * j] = wv; } }
#pragma unroll
            for (int h = 0; h < 2; ++h) { const int r = lane >> 4, c = lane & 15; const float sv = r == 0 ? sq[4 * h] : r == 1 ? sq[4 * h + 1] : r == 2 ? sq[4 * h + 2] : sq[4 * h + 3]; SS0[(size_t)(m0 + 4 * h + r) * 16 + c] = c == 0 ? sv : 0.f; }
        }
        const float* p = args.in[1]; bf16_t* PB = PBF(WS_PB);
        { const size_t NV = (size_t)2 * T * PLE / 8, st = (size_t)G * 512;
            for (size_t i = (size_t)(vcu * 512 + tid); i < NV; i += 8 * st) {
                f32x4 a[8], b[8];
#pragma unroll
                for (int q = 0; q < 8; ++q) if (i + q * st < NV) { a[q] = __builtin_nontemporal_load((const f32x4*)(p + (i + q * st) * 8)); b[q] = __builtin_nontemporal_load((const f32x4*)(p + (i + q * st) * 8 + 4)); }
#pragma unroll
                for (int q = 0; q < 8; ++q) if (i + q * st < NV) *(u32x4*)(PB + (i + q * st) * 8) = pack8(a[q], b[q]);
            } }
        if (bxp == 0) { const float* rb = args.in[2]; float* BIAS = PF32(WS_BIAS);
            for (int i = tid; i < 3 * NH * 129; i += 512) { const int g = i / (NH * 129), h = (i / 129) % NH, dist = i % 129; BIAS[i] = rb[rel_bucket(dist << (2 * g)) * NH + h] * LOG2E; } }
        if (bxp == 1) { const float* lam = args.in[20]; float* SP8 = PF32(WS_SP8);
            for (int i = tid; i < D; i += 512) SP8[i] = 8.0f * log1pf(expf(-lam[i])); }
    }
    SEAM(0);

    layer_body<0>(args, lds, G, lo, hi, wave_s, nbar);
    layer_body<1>(args, lds, G, lo, hi, wave_s, nbar);
}
#undef IN
#undef SEAM


extern "C" void kernel_launch(void* const* d_in, const int* in_sizes, int n_in, void* d_out, int out_size, void* d_ws, size_t ws_size, hipStream_t stream) {
    static int grid = 0;
    if (grid == 0) {
        if (n_in != 29 || out_size != T * D || ws_size < WS_END) { fprintf(stderr, "kernel_launch: unexpected shapes (n_in %d, out %d, ws %zu)\n", n_in, out_size, ws_size); grid = -1; return; }
        int dev = 0, cus = 0, per_cu = 0;
        hipGetDevice(&dev); hipDeviceGetAttribute(&cus, hipDeviceAttributeMultiprocessorCount, dev);
        hipFuncSetAttribute((const void*)mk_fwd, hipFuncAttributeMaxDynamicSharedMemorySize, LDS_BYTES);
        hipOccupancyMaxActiveBlocksPerMultiprocessor(&per_cu, (const void*)mk_fwd, 512, LDS_BYTES);
        if (per_cu < 1) { fprintf(stderr, "kernel_launch: occupancy query says %d blocks per CU\n", per_cu); per_cu = 1; }
        (void)hipGetLastError();
        grid = cus;
    }
    if (grid < 0) return;
    Args a{};
    for (int i = 0; i < 29; ++i) a.in[i] = (const float*)d_in[i];
    a.out = (float*)d_out; a.ws = (unsigned char*)d_ws;
    unsigned char* ws = (unsigned char*)d_ws;
    int nj = 0, start = 0;
    auto add = [&](const float* W, const float* gain, size_t wt_off, int K, int N, int mode, int row_base) {
        Job& j = a.jobs[nj++]; j.W = W; j.gain = gain; j.WT = (bf16_t*)(ws + wt_off); j.K = K; j.N = N; j.mode = mode; j.row_base = row_base; j.start = start; j.pad = 0; start += (K / 64) * (N / 32); };
    const float* const* in = a.in;
    for (int l = 0; l < 2; ++l) {
        for (int f = 0; f < 2; ++f) {
            const float* nrm = in[f == 0 ? 3 : 22] + (size_t)l * D; const float* wg = in[f == 0 ? 4 : 23] + (size_t)l * D * FF; const float* wu = in[f == 0 ? 5 : 24] + (size_t)l * D * FF; const float* wd = in[f == 0 ? 6 : 25] + (size_t)l * D * FF;
            add(wg, nrm, W_GU + (size_t)(l * 2 + f) * 11 * MiB, D, FF, 1, 0);
            add(wu, nrm, W_GU + (size_t)(l * 2 + f) * 11 * MiB, D, FF, 2, 0);
            add(wd, nullptr, W_DN + (size_t)(l * 2 + f) * 11 * MiB / 2, FF, D, 0, 0);
        }
    }
    add(in[8], in[7], W_HIN, D, 3072, 4, 0);
    add(in[12], nullptr, W_HOUT, D, D, 0, 0);
    add(in[13], in[7] + D, W_RIN, D, 2048, 0, 0);
    for (int g = 0; g < 4; ++g) { add(in[16] + (size_t)g * 65536, nullptr, W_LRU, 256, 256, 1, g * 512); add(in[18] + (size_t)g * 65536, nullptr, W_LRU, 256, 256, 2, g * 512); }
    add(in[21], nullptr, W_ROUT, D, D, 0, 0);
    for (int l = 0; l < 2; ++l) { add(in[27] + (size_t)l * D * D, in[26] + (size_t)l * D, W_PG + (size_t)l * 2 * MiB, D, D, 0, 0); add(in[28] + (size_t)l * PLE * D, nullptr, W_PPW + (size_t)l * MiB / 2, PLE, D, 0, 0); }
    a.nitems = start;
    if (nj != NJOBS) { fprintf(stderr, "kernel_launch: job count %d != %d\n", nj, NJOBS); return; }
#if MK_MULTI
    for (int ph = 0; ph < NPHASE; ++ph) { a.ph_lo = ph; a.ph_hi = ph + 1; hipLaunchKernelGGL(mk_fwd, dim3(grid), dim3(512), LDS_BYTES, stream, a); }
#else
    a.ph_lo = 0; a.ph_hi = NPHASE;
    if (hipMemsetAsync(d_ws, 0, XCD_BAR_WORDS * 4, stream) != hipSuccess) { fprintf(stderr, "kernel_launch: memset failed\n"); return; }
    void* kargs[] = {&a};
    hipError_t e = hipLaunchCooperativeKernel((const void*)mk_fwd, dim3(grid), dim3(512), kargs, LDS_BYTES, stream);
    if (e != hipSuccess) fprintf(stderr, "kernel_launch: cooperative launch failed: %s (grid %d)\n", hipGetErrorString(e), grid);
#endif
}
```
